# Optimizing an MI355X kernel written in HIP

```python
import math
import jax, jax.numpy as jnp
from jax import lax
import numpy as np


D_MODEL = 1024
BATCH = 2
SEQ = 8192
DEPTH = 1

HG_HEADS = 8
HG_DK = 128
HG_DV = D_MODEL // HG_HEADS
HG_KWIDTH = HG_HEADS * HG_DK
HG_VWIDTH = HG_HEADS * HG_DV
HG_CHUNK = 64

AT_Q_HEADS = 16
AT_KV_HEADS = 4
AT_HEAD_DIM = D_MODEL // AT_Q_HEADS
AT_GROUP = AT_Q_HEADS // AT_KV_HEADS
WINDOW = 128
AT_BLOCK = WINDOW
AT_QWIDTH = AT_Q_HEADS * AT_HEAD_DIM
AT_KVWIDTH = AT_KV_HEADS * AT_HEAD_DIM

N_EXPERTS = 32
TOP_K = 4
D_FF_EXPERT = D_MODEL
SWIGLU_LIMIT = 7.0
SWIGLU_ALPHA = 1.702
MOE_BLOCK = 128

NORM_EPS = 1e-5

IN_SIZES = (HG_KWIDTH, HG_KWIDTH, HG_KWIDTH, HG_VWIDTH, HG_VWIDTH, AT_QWIDTH, AT_KVWIDTH, AT_KVWIDTH, D_MODEL, D_MODEL)
IN_WIDTH = sum(IN_SIZES)
IN_SPLITS = tuple(int(c) for c in np.cumsum(IN_SIZES)[:-1])

kernel_name = 'hybrid_hgrn2_swa_moe_encoder_block'


def rms_norm(x, gain):
    xf = x.astype(jnp.float32)
    y = xf * lax.rsqrt(jnp.mean(xf * xf, axis=-1, keepdims=True) + NORM_EPS)
    return (y * gain.astype(jnp.float32)).astype(x.dtype)


def gla_chunkwise(q, k, v, log_f):
    bsz, seqlen, nh, dk = q.shape
    dv = v.shape[-1]
    n_chunks = seqlen // HG_CHUNK

    def chunks(t):
        return t.reshape(bsz, n_chunks, HG_CHUNK, nh, t.shape[-1]).transpose(0, 3, 1, 2, 4)

    qc = chunks(q).astype(jnp.float32)
    kc = chunks(k).astype(jnp.float32)
    vc = chunks(v).astype(jnp.float32)
    cum = jnp.cumsum(chunks(log_f).astype(jnp.float32), axis=3)
    last = cum[:, :, :, -1:, :]
    q_dec = qc * jnp.exp(cum)
    k_inv = kc * jnp.exp(-cum)
    k_end = kc * jnp.exp(last - cum)
    decay = jnp.exp(last[:, :, :, 0, :])
    tri = jnp.tril(jnp.ones((HG_CHUNK, HG_CHUNK), dtype=bool))
    scores = jnp.where(tri, jnp.einsum('bhncd,bhnsd->bhncs', q_dec, k_inv), 0.0)
    o_intra = jnp.einsum('bhncs,bhnsv->bhncv', scores, vc)

    def step(state, inp):
        qd, ke, vv, dec = inp
        o_inter = jnp.einsum('bhcd,bhdv->bhcv', qd, state)
        state = dec[..., None] * state + jnp.einsum('bhcd,bhcv->bhdv', ke, vv)
        return state, o_inter

    s0 = jnp.zeros((bsz, nh, dk, dv), jnp.float32)
    xs = (jnp.moveaxis(q_dec, 2, 0), jnp.moveaxis(k_end, 2, 0), jnp.moveaxis(vc, 2, 0), jnp.moveaxis(decay, 2, 0))
    _, o_inter = lax.scan(step, s0, xs)
    o = o_intra + jnp.moveaxis(o_inter, 0, 2)
    return o.transpose(0, 2, 3, 1, 4).reshape(bsz, seqlen, nh, dv)


def hgrn2_mixer(q_pre, f_fwd_pre, f_bwd_pre, i_val, g_pre, lb_fwd, lb_bwd, gnorm_gain):
    bsz, seqlen, _ = q_pre.shape

    def heads(t, d):
        return t.reshape(bsz, seqlen, HG_HEADS, d)

    q = heads(jax.nn.silu(q_pre), HG_DK)
    v = heads(i_val, HG_DV)

    def gate(f_pre, lb):
        f = lb + (1.0 - lb) * jax.nn.sigmoid(f_pre.astype(jnp.float32))
        return heads(1.0 - f, HG_DK), heads(jnp.log(f), HG_DK)

    k_fwd, logf_fwd = gate(f_fwd_pre, lb_fwd)
    k_bwd, logf_bwd = gate(f_bwd_pre, lb_bwd)
    flip = lambda t: jnp.flip(t, axis=1)
    o = gla_chunkwise(q, k_fwd, v, logf_fwd) + flip(gla_chunkwise(flip(q), flip(k_bwd), flip(v), flip(logf_bwd)))
    o = o * lax.rsqrt(jnp.mean(o * o, axis=-1, keepdims=True) + NORM_EPS) * gnorm_gain.astype(jnp.float32)
    o = o.reshape(bsz, seqlen, HG_VWIDTH) * jax.nn.silu(g_pre.astype(jnp.float32))
    return o.astype(q_pre.dtype)


def window_attention(q_pre, k_pre, v_pre, sink):
    bsz, seqlen, _ = q_pre.shape
    nb = seqlen // AT_BLOCK
    span = 3 * AT_BLOCK
    q = q_pre.reshape(bsz, nb, AT_BLOCK, AT_KV_HEADS, AT_GROUP, AT_HEAD_DIM)

    def band(t):
        t = t.reshape(bsz, seqlen, AT_KV_HEADS, AT_HEAD_DIM)
        t = jnp.pad(t, ((0, 0), (AT_BLOCK, AT_BLOCK), (0, 0), (0, 0)))
        t = t.reshape(bsz, nb + 2, AT_BLOCK, AT_KV_HEADS, AT_HEAD_DIM)
        return jnp.concatenate([t[:, :-2], t[:, 1:-1], t[:, 2:]], axis=2)

    kb, vb = band(k_pre), band(v_pre)
    s = jnp.einsum('bnqkgd,bnskd->bnkgqs', q, kb).astype(jnp.float32) * (AT_HEAD_DIM ** -0.5)
    rel = (jnp.arange(AT_BLOCK)[:, None] + AT_BLOCK) - jnp.arange(span)[None, :]
    key_pos = jnp.arange(nb)[:, None] * AT_BLOCK - AT_BLOCK + jnp.arange(span)[None, :]
    valid = (jnp.abs(rel) <= WINDOW)[None] & ((key_pos >= 0) & (key_pos < seqlen))[:, None, :]
    slopes = jnp.exp2(-8.0 * jnp.arange(1, AT_Q_HEADS + 1, dtype=jnp.float32) / AT_Q_HEADS)
    alibi = (-slopes[:, None, None] * jnp.abs(rel).astype(jnp.float32)).reshape(AT_KV_HEADS, AT_GROUP, AT_BLOCK, span)
    s = jnp.where(valid[None, :, None, None], s + alibi, -jnp.inf)
    sink_l = sink.astype(jnp.float32).reshape(1, 1, AT_KV_HEADS, AT_GROUP, 1, 1)
    m = jnp.maximum(jnp.max(s, axis=-1, keepdims=True), sink_l)
    p = jnp.exp(s - m)
    p = p / (jnp.sum(p, axis=-1, keepdims=True) + jnp.exp(sink_l - m))
    o = jnp.einsum('bnkgqs,bnskd->bnqkgd', p.astype(vb.dtype), vb)
    return o.reshape(bsz, seqlen, AT_QWIDTH)


def moe_ffn(xn, w_router, b_router, w_up_gate, b_up_gate, w_down, b_down):
    bsz, seqlen, d = xn.shape
    n_tok = bsz * seqlen
    n_assign = n_tok * TOP_K
    n_pad = n_assign + N_EXPERTS * MOE_BLOCK
    n_blocks = n_pad // MOE_BLOCK
    xt = xn.reshape(n_tok, d)
    logits = xt.astype(jnp.float32) @ w_router.astype(jnp.float32) + b_router.astype(jnp.float32)
    top_val, top_idx = lax.top_k(logits, TOP_K)
    gates = jax.nn.softmax(top_val, axis=-1)
    flat_e = top_idx.reshape(-1).astype(jnp.int32)
    flat_tok = jnp.repeat(jnp.arange(n_tok, dtype=jnp.int32), TOP_K)
    order = jnp.argsort(flat_e)
    sorted_e = flat_e[order]
    counts = jnp.bincount(flat_e, length=N_EXPERTS).astype(jnp.int32)
    padded = (counts + MOE_BLOCK - 1) // MOE_BLOCK * MOE_BLOCK
    grp_start = jnp.cumsum(counts) - counts
    pad_end = jnp.cumsum(padded)
    pad_start = pad_end - padded
    dest = (pad_start[sorted_e] + jnp.arange(n_assign, dtype=jnp.int32) - grp_start[sorted_e]).astype(jnp.int32)
    rows_tok = jnp.zeros((n_pad,), jnp.int32).at[dest].set(flat_tok[order])
    block_expert = jnp.minimum(jnp.searchsorted(pad_end, jnp.arange(n_blocks, dtype=jnp.int32) * MOE_BLOCK, side='right'), N_EXPERTS - 1)
    xb = xt[rows_tok].reshape(n_blocks, MOE_BLOCK, d)

    def expert_block(args):
        xblk, e = args
        hu = xblk @ w_up_gate[e] + b_up_gate[e]
        g, u = hu[:, :D_FF_EXPERT], hu[:, D_FF_EXPERT:]
        g = jnp.minimum(g, SWIGLU_LIMIT)
        u = jnp.clip(u, -SWIGLU_LIMIT, SWIGLU_LIMIT)
        act = g * jax.nn.sigmoid(SWIGLU_ALPHA * g) * (u + 1.0)
        return act @ w_down[e] + b_down[e]

    yb = lax.map(expert_block, (xb, block_expert)).reshape(n_pad, d)
    dest_of_assign = jnp.zeros((n_assign,), jnp.int32).at[order].set(dest)
    y = yb[dest_of_assign].reshape(n_tok, TOP_K, d)
    out = jnp.einsum('tk,tkd->td', gates.astype(y.dtype), y)
    return out.reshape(bsz, seqlen, d)


def setup_inputs(seed: int = 0) -> dict:
    key = jax.random.key(seed)
    ks = jax.random.split(key, 16)
    f32 = jnp.float32

    def nrm(k, shape, scale):
        return scale * jax.random.normal(k, shape, f32)

    x = jax.random.normal(ks[0], (BATCH, SEQ, D_MODEL), f32)
    norm_mix_gain = 1.0 + nrm(ks[1], (DEPTH, D_MODEL), 0.01)
    w_in = nrm(ks[2], (DEPTH, D_MODEL, IN_WIDTH), D_MODEL ** -0.5)
    hg_lb_fwd = nrm(ks[3], (DEPTH + 1, HG_KWIDTH), 0.1)
    hg_lb_bwd = nrm(ks[4], (DEPTH + 1, HG_KWIDTH), 0.1)
    hg_norm_gain = 1.0 + nrm(ks[5], (DEPTH, HG_DV), 0.01)
    attn_sink = nrm(ks[6], (DEPTH, AT_Q_HEADS), 0.5)
    w_out = nrm(ks[7], (DEPTH, D_MODEL, D_MODEL), D_MODEL ** -0.5)
    norm_ffn_gain = 1.0 + nrm(ks[8], (DEPTH, D_MODEL), 0.01)
    w_router = nrm(ks[9], (DEPTH, D_MODEL, N_EXPERTS), D_MODEL ** -0.5)
    b_router = nrm(ks[10], (DEPTH, N_EXPERTS), 0.01)
    w_up_gate = nrm(ks[11], (DEPTH, N_EXPERTS, D_MODEL, 2 * D_FF_EXPERT), D_MODEL ** -0.5)
    b_up_gate = nrm(ks[12], (DEPTH, N_EXPERTS, 2 * D_FF_EXPERT), 0.01)
    w_down = nrm(ks[13], (DEPTH, N_EXPERTS, D_FF_EXPERT, D_MODEL), D_FF_EXPERT ** -0.5)
    b_down = nrm(ks[14], (DEPTH, N_EXPERTS, D_MODEL), 0.01)
    final_norm_gain = 1.0 + nrm(ks[15], (D_MODEL,), 0.01)
    return {'x': x, 'norm_mix_gain': norm_mix_gain, 'w_in': w_in, 'hg_lb_fwd': hg_lb_fwd,
            'hg_lb_bwd': hg_lb_bwd, 'hg_norm_gain': hg_norm_gain, 'attn_sink': attn_sink,
            'w_out': w_out, 'norm_ffn_gain': norm_ffn_gain, 'w_router': w_router,
            'b_router': b_router, 'w_up_gate': w_up_gate, 'b_up_gate': b_up_gate,
            'w_down': w_down, 'b_down': b_down, 'final_norm_gain': final_norm_gain}


def reference(x, norm_mix_gain, w_in, hg_lb_fwd, hg_lb_bwd, hg_norm_gain, attn_sink, w_out,
              norm_ffn_gain, w_router, b_router, w_up_gate, b_up_gate, w_down, b_down,
              final_norm_gain):
    lb_fwd_all = jnp.cumsum(jax.nn.softmax(hg_lb_fwd.astype(jnp.float32), axis=0), axis=0)
    lb_bwd_all = jnp.cumsum(jax.nn.softmax(hg_lb_bwd.astype(jnp.float32), axis=0), axis=0)
    h = x
    for layer in range(DEPTH):
        xn = rms_norm(h, norm_mix_gain[layer])
        proj = xn @ w_in[layer]
        hq, hf_fwd, hf_bwd, hi, hg, aq, ak, av, gate_a, gate_b = jnp.split(proj, IN_SPLITS, axis=-1)
        y_rec = hgrn2_mixer(hq, hf_fwd, hf_bwd, hi, hg, lb_fwd_all[layer], lb_bwd_all[layer], hg_norm_gain[layer])
        y_att = window_attention(aq, ak, av, attn_sink[layer])
        merged = jax.nn.sigmoid(gate_a) * y_rec + jax.nn.sigmoid(gate_b) * y_att
        h = h + merged @ w_out[layer]
        h = h + moe_ffn(rms_norm(h, norm_ffn_gain[layer]), w_router[layer], b_router[layer],
                        w_up_gate[layer], b_up_gate[layer], w_down[layer], b_down[layer])
    return rms_norm(h, final_norm_gain)
```

```cpp
#include <hip/hip_runtime.h>
#include <cstdio>
#include <cstdint>

typedef unsigned short bf16;
#define DI __device__ __forceinline__

constexpr int NB = 2, SEQ = 8192, T = NB * SEQ, D = 1024;
constexpr int HGH = 8, DK = 128, DV = 128, CH = 64, NCH = SEQ / CH;
constexpr int AQH = 16, AKH = 4, AHD = 64, WIN = 128;
constexpr int NE = 32, TOPK = 4, FF = 1024;
constexpr float EPS = 1e-5f, SW_LIM = 7.0f, SW_ALPHA = 1.702f;
constexpr int INW = 8704;
constexpr int C_HQ = 0, C_FF = 1024, C_FB = 2048, C_HI = 3072, C_HG = 4096, C_AQ = 5120, C_AK = 6144, C_AV = 6400, C_GA = 6656, C_GB = 7680;
constexpr int NATW = 5376, N_Q = 0, N_G = 1024, N_AQ = 2048, N_AK = 3072, N_GA = 3328, N_GB = 4352;
constexpr int TRW = 3328, R_GF = 0, R_GB = 1024, R_V = 2048, R_AV = 3072;
constexpr int NPAD = T * TOPK + NE * 256;
constexpr float QSCALE = 0.125f * 1.4426950408889634f;
constexpr int NAT16 = 2048, TR8 = 2048;
constexpr float W8_SCALE = 32.0f, W8_INV = 1.0f / 32.0f;

constexpr size_t MiB = 1u << 20;
constexpr size_t WS_CTL = 0;
constexpr size_t WS_WUG = 1 * MiB;
constexpr size_t WS_WD = WS_WUG + 128 * MiB;
constexpr size_t WS_WOUT = WS_WD + 64 * MiB;
constexpr size_t WS_H = WS_WOUT + 2 * MiB;
constexpr size_t WS_MERGED = WS_H + 64 * MiB;
constexpr size_t WS_TK = WS_MERGED + 32 * MiB;
constexpr size_t WS_B = WS_TK + 1 * MiB;
constexpr size_t WS_WIN = WS_B;
constexpr size_t WS_XN = WS_WIN + 17 * MiB;
constexpr size_t WS_PN = WS_XN + 32 * MiB;
constexpr size_t WS_PT = WS_PN + 168 * MiB;
constexpr size_t WS_YA = WS_PT + 104 * MiB;
constexpr size_t WS_U = WS_YA + 32 * MiB;
constexpr size_t WS_DEC = WS_U + 128 * MiB;
constexpr size_t WS_OF = WS_DEC + 2 * MiB;
constexpr size_t WS_WIN8 = WS_OF, WS_XN8 = WS_OF + 16 * MiB;
constexpr size_t WS_B_END = WS_OF + 128 * MiB;
constexpr size_t WS_XN2 = WS_B;
constexpr size_t WS_XG = WS_XN2 + 32 * MiB;
constexpr size_t WS_ACT = WS_XG + 144 * MiB;
constexpr size_t WS_YB = WS_ACT + 144 * MiB;
constexpr size_t WS_END = (WS_B_END > WS_YB + 144 * MiB) ? WS_B_END : (WS_YB + 144 * MiB);
static_assert(true, "");
constexpr int CW_CNT = 1024, CNT_STRIDE = 64;
constexpr int CW_BAR = 4096;

DI float bf2f(bf16 b) { return __uint_as_float((unsigned)b << 16); }
DI bf16 f2bf(float f) { unsigned u = __float_as_uint(f); return (bf16)((u + 0x7fffu + ((u >> 16) & 1u)) >> 16); }
DI float sigmoidf_(float x) { return 1.0f / (1.0f + __expf(-x)); }
DI float wave_sum(float v) {
#pragma unroll
    for (int o = 1; o < 64; o <<= 1) v += __shfl_xor(v, o);
    return v;
}

DI int win_row_to_col(int r) {
    if (r < NATW) {
        if (r < N_G) return C_HQ + r;
        if (r < N_AQ) return C_HG + (r - N_G);
        if (r < N_AK) return C_AQ + (r - N_AQ);
        if (r < N_GA) return C_AK + (r - N_AK);
        if (r < N_GB) return C_GA + (r - N_GA);
        return C_GB + (r - N_GB);
    }
    r -= NATW;
    if (r < R_GB) return C_FF + r;
    if (r < R_V) return C_FB + (r - R_GB);
    if (r < R_AV) return C_HI + (r - R_V);
    return C_AV + (r - R_AV);
}
DI int wug_row_to_col(int p) { const int tile = p >> 8, c = p & 255; return c < 128 ? (tile * 128 + c) : (1024 + tile * 128 + (c - 128)); }

namespace pg8 {
#define PG8_LAS __attribute__((address_space(3)))
typedef unsigned short bf16_t;
typedef short bf16x8 __attribute__((ext_vector_type(8)));
typedef float f32x4 __attribute__((ext_vector_type(4)));
typedef unsigned u32x4 __attribute__((ext_vector_type(4)));
constexpr int BM = 256, BK = 64, HALF = 128, HTB = HALF * BK * 2  , STAGE_BYTES = 8 * HTB, NXCD = 8, WGM = 8;

__host__ __device__ __forceinline__ int lds_byte(int r, int c) { const int st = (r >> 4) * 2 + (c >> 5), rr = r & 15, cc = c & 31, ob = rr * 64 + cc * 2; return st * 1024 + (ob ^ (((ob >> 9) & 1) << 5)); }
__host__ __device__ __forceinline__ void stage_rc(int b, int& R, int& C) { const int st = b / 1024, sb = b % 1024, swz = sb ^ (((sb >> 9) & 1) << 5); R = (st >> 1) * 16 + swz / 64; C = (st & 1) * 32 + (swz % 64) / 2; }
__host__ __device__ __forceinline__ int perm32(int rho) { const int n = rho >> 4, i = rho & 15; return 8 * (i >> 2) + 4 * n + (i & 3); }

struct Unit { int pm, pn; int e, r0, cnt; };
struct Gemm { const bf16_t* A; const bf16_t* Bt; int M, N, K; };

struct StaticOrder {
    static constexpr bool GATHER = false;
    int nM, nN, nwg, G, c;
    __host__ __device__ void init(int M, int N, int G_, int c_) { nM = M / BM; nN = N / BM; nwg = nM * nN; G = G_; c = c_; }
    __host__ __device__ bool next(int i, Unit& u) const {
        const long L = (long)i * G + c; if (L >= nwg) return false;
        int wgid = (int)L; { const int q = nwg / NXCD, r = nwg % NXCD, xcd = wgid % NXCD, off = wgid / NXCD; wgid = (xcd < r ? xcd * (q + 1) : r * (q + 1) + (xcd - r) * q) + off; }
        const int nig = WGM * nN, gid = wgid / nig, fm = gid * WGM, gsz = (nM - fm) < WGM ? (nM - fm) : WGM;
        u.pm = fm + ((wgid % nig) % gsz); u.pn = (wgid % nig) / gsz; return true;
    }
    __device__ __forceinline__ void a_ready(const Unit&) const {}
    __device__ __forceinline__ void done(const Unit&) const {}
};
__device__ __forceinline__ unsigned cvt_pk_bf16(float lo, float hi) {
    typedef float f2_ __attribute__((ext_vector_type(2))); typedef __bf16 b2_ __attribute__((ext_vector_type(2))); const f2_ v = {lo, hi}; return __builtin_bit_cast(unsigned, __builtin_convertvector(v, b2_)); }
template <class Epi, class Sched, bool ALIGN_EPI = false, bool SP2 = false, bool FP8 = false>
__device__ __forceinline__ void gemm_phase(PG8_LAS unsigned char* lds, const Gemm g, const Sched& S, const Epi& E) {
    const int tid = threadIdx.x, wid = __builtin_amdgcn_readfirstlane(tid >> 6), lane = tid & 63, wr = wid >> 2, wc = wid & 3, fr = lane & 15, fq = lane >> 4;
    const int K = g.K, nt = K / BK;
    unsigned voffA[2], voffB[2];
    unsigned gv[2][2], gvn[2][2];
#pragma unroll
    for (int i = 0; i < 2; ++i) { int R, C; stage_rc(tid * 16 + i * 8192, R, C); const int Rb = Epi::PERM ? ((R & ~31) + perm32(R & 31)) : R;
        voffA[i] = (unsigned)(R * K + C) * 2u; voffB[i] = (unsigned)(Rb * K + C) * 2u; }
    const size_t kstep = (size_t)(BK * 2);
    const size_t hstep = (size_t)HALF * K * 2;
    const size_t tstep = 2 * hstep;
    const unsigned ldsw = (unsigned)wid * 1024u;
    const int aoff = lds_byte(wr * 64 + fr, fq * 8), boff = lds_byte(wc * 32 + fr, fq * 8);
#define PG8_SA(b, h) (((b) * 2 + (h)) * HTB)
#define PG8_SB(b, h) ((4 + (b) * 2 + (h)) * HTB)
#define PG8_STAGE(bufoff, gbase, voff) do { _Pragma("unroll") for (int _i = 0; _i < 2; ++_i) \
        __builtin_amdgcn_global_load_lds((const unsigned*)((const char*)(gbase) + (voff)[_i]), (PG8_LAS unsigned*)(lds + (bufoff) + ldsw + _i * 8192), 16, 0, 0); } while (0)
#define PG8_LDA(dst, b, h) do { if constexpr (FP8) { _Pragma("unroll") for (int m = 0; m < 4; ++m) { const v4i_ lo_ = *(const PG8_LAS v4i_*)(lds + PG8_SA(b, h) + aoff + m * 2048), hi_ = *(const PG8_LAS v4i_*)(lds + PG8_SA(b, h) + aoff + m * 2048 + 1024); dst##8[m] = __builtin_shufflevector(lo_, hi_, 0, 1, 2, 3, 4, 5, 6, 7); } } \
        else { _Pragma("unroll") for (int m = 0; m < 4; ++m) _Pragma("unroll") for (int k = 0; k < 2; ++k) dst[m][k] = *(const PG8_LAS bf16x8*)(lds + PG8_SA(b, h) + aoff + m * 2048 + k * 1024); } } while (0)
#define PG8_LDB(dst, b, h) do { if constexpr (FP8) { _Pragma("unroll") for (int n = 0; n < 2; ++n) { const v4i_ lo_ = *(const PG8_LAS v4i_*)(lds + PG8_SB(b, h) + boff + n * 2048), hi_ = *(const PG8_LAS v4i_*)(lds + PG8_SB(b, h) + boff + n * 2048 + 1024); dst##8[n] = __builtin_shufflevector(lo_, hi_, 0, 1, 2, 3, 4, 5, 6, 7); } } \
        else { _Pragma("unroll") for (int n = 0; n < 2; ++n) _Pragma("unroll") for (int k = 0; k < 2; ++k) dst[n][k] = *(const PG8_LAS bf16x8*)(lds + PG8_SB(b, h) + boff + n * 2048 + k * 1024); } } while (0)
#define PG8_MMA(ai, bj, At, Bt) do { __builtin_amdgcn_s_setprio(1); _Pragma("unroll") for (int m = 0; m < 4; ++m) _Pragma("unroll") for (int n = 0; n < 2; ++n) { \
        if constexpr (FP8) asm volatile("v_mfma_scale_f32_16x16x128_f8f6f4 %0, %1, %2, %0, %3, %3 op_sel_hi:[0,0,0]" : "+v"(acc[ai][bj][m][n]) : "v"(Bt##8[n]), "v"(At##8[m]), "v"(one_scale));   \
        else { _Pragma("unroll") for (int k = 0; k < 2; ++k) acc[ai][bj][m][n] = __builtin_amdgcn_mfma_f32_16x16x32_bf16(Bt[n][k], At[m][k], acc[ai][bj][m][n], 0, 0, 0); } } \
        __builtin_amdgcn_s_setprio(0); } while (0)
#define PG8_WAIT_V(n) asm volatile("s_waitcnt vmcnt(" #n ")" ::: "memory")
#define PG8_WAIT_L(n) asm volatile("s_waitcnt lgkmcnt(" #n ")" ::: "memory")
#define PG8_BAR __builtin_amdgcn_s_barrier()
#define PG8_SCHED __builtin_amdgcn_sched_barrier(0)
    Unit cur, nxt, nn; int ui = 0;
    if (!S.next(0, cur)) return;
    bool has_next = S.next(1, nxt);
    f32x4 acc[2][2][4][2];
#pragma unroll
    for (int a = 0; a < 2; ++a)
#pragma unroll
        for (int b = 0; b < 2; ++b)
#pragma unroll
            for (int m = 0; m < 4; ++m)
#pragma unroll
                for (int n = 0; n < 2; ++n) { acc[a][b][m][n] = (f32x4){0.f, 0.f, 0.f, 0.f}; }
    if constexpr (Epi::INIT_ACC) E.init_acc(acc, cur, wr, wc, fr, fq);
    typedef int v8i_ __attribute__((ext_vector_type(8))); typedef int v4i_ __attribute__((ext_vector_type(4)));
    int one_scale = 0x7f7f7f7f; asm volatile("" : "+v"(one_scale));
    bf16x8 At[4][2], B0[2][2], B1[2][2]; v8i_ At8[4], B08[2], B18[2];
    const char* cA = (const char*)g.A + (Sched::GATHER ? (size_t)0 : (size_t)cur.pm * tstep); const char* cB = (const char*)g.Bt + (size_t)cur.pn * tstep;
    if constexpr (Sched::GATHER) { S.gather_voffs(cur, K, tid, gv); if (has_next) S.gather_voffs(nxt, K, tid, gvn); }
#define PG8_STAGEA(bufoff, ptr, h, nx) do { if constexpr (Sched::GATHER) { const unsigned sel_[2] = {(nx) ? gvn[h][0] : gv[h][0], (nx) ? gvn[h][1] : gv[h][1]}; PG8_STAGE(bufoff, ptr, sel_); } \
        else { PG8_STAGE(bufoff, (ptr) + (h) * hstep, voffA); } } while (0)
    S.a_ready(cur);
    if constexpr (SP2) {
        PG8_STAGE(PG8_SB(0, 0), cB, voffB); PG8_STAGE(PG8_SB(0, 1), cB + hstep, voffB); PG8_STAGEA(PG8_SA(0, 0), cA, 0, false); PG8_STAGEA(PG8_SA(0, 1), cA, 1, false);
        if (wr == 1) PG8_BAR;
        PG8_WAIT_V(2); PG8_BAR;
        PG8_STAGE(PG8_SB(1, 0), cB + kstep, voffB); PG8_STAGEA(PG8_SA(1, 0), cA + kstep, 0, false); PG8_STAGE(PG8_SB(1, 1), cB + hstep + kstep, voffB);
        PG8_WAIT_V(6); PG8_BAR;
    } else {
        PG8_STAGE(PG8_SB(0, 0), cB, voffB); PG8_STAGE(PG8_SA(0, 0), cA, voffA); PG8_STAGE(PG8_SB(0, 1), cB + hstep, voffB); PG8_STAGE(PG8_SA(0, 1), cA + hstep, voffA);
        if (wr == 1) PG8_BAR;
        PG8_WAIT_V(4); PG8_BAR;
        PG8_STAGE(PG8_SB(1, 0), cB + kstep, voffB); PG8_STAGE(PG8_SA(1, 0), cA + kstep, voffA); PG8_STAGE(PG8_SB(1, 1), cB + hstep + kstep, voffB);
        PG8_WAIT_V(6); PG8_BAR;
    }
    for (;;) {
        const char* nA = has_next ? (const char*)g.A + (Sched::GATHER ? (size_t)0 : (size_t)nxt.pm * tstep) : cA; const char* nB = has_next ? (const char*)g.Bt + (size_t)nxt.pn * tstep : cB;
#pragma unroll 1
        for (int t = 0; t < nt; t += 2) {
            const bool last = (t == nt - 2); const bool nx = last && has_next;
            const char* a1 = cA + (size_t)(t + 1) * kstep;
            const char* a2 = last ? nA : cA + (size_t)(t + 2) * kstep; const char* b2 = last ? nB : cB + (size_t)(t + 2) * kstep;
            const char* a3 = a2 + kstep; const char* b3 = b2 + kstep;
            if (last && has_next) S.a_ready(nxt);
            if constexpr (SP2) {
            PG8_LDB(B0, 0, 0); PG8_LDB(B1, 0, 1); PG8_SCHED; PG8_LDA(At, 0, 0); PG8_STAGEA(PG8_SA(1, 1), a1, 1, false);
            PG8_WAIT_V(8); PG8_WAIT_L(0); PG8_BAR; PG8_MMA(0, 0, At, B0); PG8_MMA(0, 1, At, B1); PG8_BAR; PG8_SCHED;
            PG8_LDA(At, 0, 1); PG8_STAGE(PG8_SB(0, 0), b2, voffB); PG8_STAGE(PG8_SB(0, 1), b2 + hstep, voffB); PG8_STAGEA(PG8_SA(0, 0), a2, 0, nx);
            PG8_WAIT_V(8); PG8_WAIT_L(0); PG8_BAR; PG8_MMA(1, 0, At, B0); PG8_MMA(1, 1, At, B1); PG8_BAR; PG8_SCHED;
            PG8_LDB(B0, 1, 0); PG8_LDB(B1, 1, 1); PG8_SCHED; PG8_LDA(At, 1, 0); PG8_STAGEA(PG8_SA(0, 1), a2, 1, nx);
            PG8_WAIT_V(8); PG8_WAIT_L(0); PG8_BAR; PG8_MMA(0, 0, At, B0); PG8_MMA(0, 1, At, B1); PG8_BAR; PG8_SCHED;
            PG8_LDA(At, 1, 1); PG8_STAGE(PG8_SB(1, 0), b3, voffB); PG8_STAGE(PG8_SB(1, 1), b3 + hstep, voffB); PG8_STAGEA(PG8_SA(1, 0), a3, 0, nx);
            PG8_WAIT_V(8); PG8_WAIT_L(0); PG8_BAR; PG8_MMA(1, 0, At, B0); PG8_MMA(1, 1, At, B1); PG8_BAR; PG8_SCHED;
            } else {
            PG8_LDB(B0, 0, 0); PG8_SCHED; PG8_LDA(At, 0, 0); PG8_STAGE(PG8_SA(1, 1), a1 + hstep, voffA);
            PG8_WAIT_L(8); PG8_BAR; PG8_WAIT_L(0); PG8_MMA(0, 0, At, B0); PG8_BAR; PG8_SCHED;
            PG8_LDB(B1, 0, 1); PG8_STAGE(PG8_SB(0, 0), b2, voffB);
            PG8_BAR; PG8_WAIT_L(0); PG8_MMA(0, 1, At, B1); PG8_BAR;
            PG8_LDA(At, 0, 1); PG8_STAGE(PG8_SA(0, 0), a2, voffA);
            PG8_BAR; PG8_WAIT_L(0); PG8_MMA(1, 0, At, B0); PG8_BAR; PG8_SCHED;
            PG8_STAGE(PG8_SB(0, 1), b2 + hstep, voffB);
            PG8_WAIT_V(6); PG8_BAR; PG8_MMA(1, 1, At, B1); PG8_BAR;
            PG8_LDB(B0, 1, 0); PG8_SCHED; PG8_LDA(At, 1, 0); PG8_STAGE(PG8_SA(0, 1), a2 + hstep, voffA);
            PG8_WAIT_L(8); PG8_BAR; PG8_WAIT_L(0); PG8_MMA(0, 0, At, B0); PG8_BAR; PG8_SCHED;
            PG8_LDB(B1, 1, 1); PG8_STAGE(PG8_SB(1, 0), b3, voffB);
            PG8_BAR; PG8_WAIT_L(0); PG8_MMA(0, 1, At, B1); PG8_BAR;
            PG8_LDA(At, 1, 1); PG8_STAGE(PG8_SA(1, 0), a3, voffA);
            PG8_BAR; PG8_WAIT_L(0); PG8_MMA(1, 0, At, B0); PG8_BAR; PG8_SCHED;
            PG8_STAGE(PG8_SB(1, 1), b3 + hstep, voffB);
            PG8_WAIT_V(6); PG8_BAR; PG8_MMA(1, 1, At, B1); PG8_BAR;
            }
        }
        if constexpr (FP8) asm volatile("s_nop 15\n\ts_nop 15" ::: "memory");
        else asm volatile("s_nop 15" ::: "memory");
        if constexpr (ALIGN_EPI) { if (wr == 0) PG8_BAR; }
        bool has_nn = false; int gtok[2][2];
        if (has_next) { has_nn = S.next(ui + 2, nn); if constexpr (Sched::GATHER) { if (has_nn) S.gather_issue(nn, tid, gtok); } }
        if constexpr (!Epi::AFTER_DRAIN) { E(acc, cur, wr, wc, fr, fq); S.done(cur); }
        if (!has_next) break;
#pragma unroll
        for (int a = 0; a < 2; ++a)
#pragma unroll
            for (int b = 0; b < 2; ++b)
#pragma unroll
                for (int m = 0; m < 4; ++m)
#pragma unroll
                    for (int n = 0; n < 2; ++n) { acc[a][b][m][n] = (f32x4){0.f, 0.f, 0.f, 0.f}; }
        if constexpr (Epi::INIT_ACC) E.init_acc(acc, nxt, wr, wc, fr, fq);
        cur = nxt; cA = nA; cB = nB; ++ui;
        if constexpr (Sched::GATHER) { gv[0][0] = gvn[0][0]; gv[0][1] = gvn[0][1]; gv[1][0] = gvn[1][0]; gv[1][1] = gvn[1][1]; if (has_nn) S.gather_finish(gtok, K, tid, gvn); }
        nxt = nn; has_next = has_nn;
        if constexpr (ALIGN_EPI) { if (wr == 1) PG8_BAR; }
    }
    PG8_WAIT_V(0);
    if constexpr (!ALIGN_EPI) { if (wr == 0) PG8_BAR; }
    PG8_BAR;
    if constexpr (Epi::AFTER_DRAIN) { E.fused(acc, cur, wr, wc, fr, fq, lds, wid, lane); S.done(cur); }
#undef PG8_SA
#undef PG8_SB
#undef PG8_STAGE
#undef PG8_STAGEA
#undef PG8_LDA
#undef PG8_LDB
#undef PG8_MMA
#undef PG8_WAIT_V
#undef PG8_WAIT_L
#undef PG8_BAR
#undef PG8_SCHED
}
}

DI size_t ptb_blk(int f, int t) { return ((size_t)(f >> 4) * (T / 32) + (t >> 5)) * 512; }
DI size_t pn_stripe(size_t tok) { return (tok >> 4) * (size_t)(16 * NATW); }
DI size_t ya_stripe(size_t tok) { return (tok >> 4) * (size_t)(16 * D); }
namespace pg8 {
typedef float f32x2 __attribute__((ext_vector_type(2)));
DI float fsig(float x) { return __builtin_amdgcn_rcpf(1.0f + __expf(-x)); }
template <bool GATES> struct EpiNatMk {
    static constexpr bool PERM = true, AFTER_DRAIN = false, INIT_ACC = false;
    bf16_t* O; int ctoff;
    template <int MODE, int LAY, bool F8> DI void body(const f32x4 (&acc)[2][2][4][2], const Unit& u, int wr, int wc, int fr, int fq) const {
        const int row0 = u.pm * BM + wr * 64 + fr, colt = (u.pn + ctoff) * BM, col0 = colt + wc * 32 + 8 * fq;
        constexpr float sc = F8 ? W8_INV : 1.0f, nl2 = -1.4426950408889634f * sc;
#pragma unroll
        for (int ai = 0; ai < 2; ++ai)
#pragma unroll
            for (int m = 0; m < 4; ++m) { bf16_t* sp = O + pn_stripe((size_t)(row0 + ai * HALF + m * 16));
#pragma unroll
                for (int bj = 0; bj < 2; ++bj) { float v[8]; const int c0 = col0 + bj * HALF;
#pragma unroll
                    for (int j = 0; j < 8; ++j) { const float a = acc[ai][bj][m][j >> 2][j & 3];
                        if constexpr (MODE == 0) v[j] = (F8 ? a * sc : a) * __builtin_amdgcn_rcpf(1.0f + __builtin_amdgcn_exp2f(a * nl2));
                        else if constexpr (MODE == 1) v[j] = a * (QSCALE * sc);
                        else if constexpr (MODE == 2) v[j] = F8 ? a * sc : a;
                        else v[j] = __builtin_amdgcn_rcpf(1.0f + __builtin_amdgcn_exp2f(a * nl2)); }
                    u32x4 w; w.x = cvt_pk_bf16(v[0], v[1]); w.y = cvt_pk_bf16(v[2], v[3]); w.z = cvt_pk_bf16(v[4], v[5]); w.w = cvt_pk_bf16(v[6], v[7]);
                    if constexpr (LAY == 1) *(u32x4*)(sp + (c0 >> 5) * 512 + ((((c0 & 31) >> 3) * 16 + fr) * 8)) = w;
                    else if constexpr (LAY == 0) { const int gg = (c0 & 15) >> 2, hf = (c0 >> 4) & 1; bf16_t* bp = sp + (c0 >> 5) * 512 + hf * 4;
                        *(uint2*)(bp + (gg * 16 + fr) * 8) = make_uint2(w.x, w.y); *(uint2*)(bp + ((gg + 1) * 16 + fr) * 8) = make_uint2(w.z, w.w); }
                    else { const int gg = (c0 & 15) >> 2; bf16_t* bp = sp + (c0 >> 4) * 256 + fr * 4;
                        *(uint2*)(bp + gg * 64) = make_uint2(w.x, w.y); *(uint2*)(bp + (gg + 1) * 64) = make_uint2(w.z, w.w); } } }
    }
    DI void operator()(const f32x4 (&acc)[2][2][4][2], const Unit& u, int wr, int wc, int fr, int fq) const {
        if constexpr (GATES) { const int colt = __builtin_amdgcn_readfirstlane((u.pn + ctoff) * BM);
            if (colt < N_AK) body<1, 1, true>(acc, u, wr, wc, fr, fq); else if (colt < N_GA) body<2, 1, true>(acc, u, wr, wc, fr, fq); else body<3, 2, true>(acc, u, wr, wc, fr, fq); }
        else { const int colt = __builtin_amdgcn_readfirstlane((u.pn + ctoff) * BM);
            if (colt < N_G) body<0, 0, false>(acc, u, wr, wc, fr, fq); else if (colt < N_AQ) body<0, 2, false>(acc, u, wr, wc, fr, fq);
            else if (colt < N_AK) body<1, 1, false>(acc, u, wr, wc, fr, fq); else body<2, 1, false>(acc, u, wr, wc, fr, fq); }
    }
};
template <bool ISG> struct EpiTrMk {
    static constexpr bool PERM = true, AFTER_DRAIN = false, INIT_ACC = false;
    bf16_t* O; const float* lbf; const float* lbb; int rtoff;
    DI void operator()(const f32x4 (&acc)[2][2][4][2], const Unit& u, int wr, int wc, int fr, int fq) const {
        const int pmr = u.pm + rtoff, row0 = pmr * BM + wr * 64 + fr, col0 = u.pn * BM + wc * 32 + 8 * fq;
        float lbv[2][4];
        if constexpr (ISG) { const float* tb = pmr < 4 ? lbf : lbb;
#pragma unroll
            for (int ai = 0; ai < 2; ++ai)
#pragma unroll
                for (int m = 0; m < 4; ++m) { const int c = (row0 + ai * HALF + m * 16) & 1023; lbv[ai][m] = __builtin_amdgcn_rcpf(1.0f + __builtin_amdgcn_exp2f((tb[1024 + c] - tb[c]) * 1.4426950408889634f)); } }
#pragma unroll
        for (int ai = 0; ai < 2; ++ai)
#pragma unroll
            for (int m = 0; m < 4; ++m) { const int row = row0 + ai * HALF + m * 16;
                const float lb = ISG ? lbv[ai][m] : 0.f, omlb = 1.0f - lb;
#pragma unroll
                for (int bj = 0; bj < 2; ++bj) { float v[8]; const int t0 = col0 + bj * HALF;
#pragma unroll
                    for (int j = 0; j < 8; ++j) { const float a = acc[ai][bj][m][j >> 2][j & 3];
                        if constexpr (ISG) v[j] = 0.6931471805599453f * __builtin_amdgcn_logf(lb + omlb * __builtin_amdgcn_rcpf(1.0f + __builtin_amdgcn_exp2f(a * (-1.4426950408889634f * W8_INV))));
                        else v[j] = a; }
                    u32x4 w; w.x = cvt_pk_bf16(v[0], v[1]); w.y = cvt_pk_bf16(v[2], v[3]); w.z = cvt_pk_bf16(v[4], v[5]); w.w = cvt_pk_bf16(v[6], v[7]);
                    bf16_t* bp = O + ptb_blk(row, t0);
                    if constexpr (ISG) *(u32x4*)(bp + ((((t0 & 31) >> 3) * 16 + fr) * 8)) = w;
                    else { const int gg = (t0 & 15) >> 2, hf = (t0 >> 4) & 1;
                        *(uint2*)(bp + (gg * 16 + fr) * 8 + hf * 4) = make_uint2(w.x, w.y); *(uint2*)(bp + ((gg + 1) * 16 + fr) * 8 + hf * 4) = make_uint2(w.z, w.w); } } }
    }
};
struct EpiResidMk {
    static constexpr bool PERM = true, AFTER_DRAIN = false, INIT_ACC = true;
    const float* x; bf16_t* h;
    DI void init_acc(f32x4 (&acc)[2][2][4][2], const Unit& u, int wr, int wc, int fr, int fq) const {
        const int row0 = u.pm * BM + wr * 64 + fr, col0 = u.pn * BM + wc * 32 + 8 * fq;
#pragma unroll
        for (int ai = 0; ai < 2; ++ai)
#pragma unroll
            for (int m = 0; m < 4; ++m) { const size_t off = (size_t)(row0 + ai * HALF + m * 16) * D + col0;
#pragma unroll
                for (int bj = 0; bj < 2; ++bj)
#pragma unroll
                    for (int n = 0; n < 2; ++n) acc[ai][bj][m][n] = *(const f32x4*)(x + off + bj * HALF + n * 4); }
    }
    DI void operator()(const f32x4 (&acc)[2][2][4][2], const Unit& u, int wr, int wc, int fr, int fq) const {
        const int row0 = u.pm * BM + wr * 64 + fr, col0 = u.pn * BM + wc * 32 + 8 * fq;
#pragma unroll
        for (int ai = 0; ai < 2; ++ai)
#pragma unroll
            for (int m = 0; m < 4; ++m) { const size_t off = (size_t)(row0 + ai * HALF + m * 16) * D + col0;
#pragma unroll
                for (int bj = 0; bj < 2; ++bj) { const f32x4 a = acc[ai][bj][m][0], b = acc[ai][bj][m][1];
                    u32x4 w; w.x = cvt_pk_bf16(a[0], a[1]); w.y = cvt_pk_bf16(a[2], a[3]); w.z = cvt_pk_bf16(b[0], b[1]); w.w = cvt_pk_bf16(b[2], b[3]);
                    *(u32x4*)(h + off + bj * HALF) = w; } }
    }
};
struct EpiSwigluMk {
    static constexpr bool PERM = true, AFTER_DRAIN = false, INIT_ACC = false;
    unsigned char* O; const float* bias;
    DI void operator()(const f32x4 (&acc)[2][2][4][2], const Unit& u, int wr, int wc, int fr, int fq) const {
        const int e = u.pn >> 3, ct = u.pn & 7, row0 = u.pm * BM + wr * 64 + fr, ffc0 = ct * 128 + wc * 32 + 8 * fq;
        const float* bgp = bias + (size_t)e * 2048 + ffc0; const float* bup = bgp + 1024;
        const f32x4 bg0 = *(const f32x4*)bgp, bg1 = *(const f32x4*)(bgp + 4), bu0 = *(const f32x4*)bup, bu1 = *(const f32x4*)(bup + 4);
#pragma unroll
        for (int ai = 0; ai < 2; ++ai)
#pragma unroll
            for (int m = 0; m < 4; ++m) { int w[2] = {0, 0};
#pragma unroll
                for (int n = 0; n < 2; ++n) { const f32x4 bg = n ? bg1 : bg0, bu = n ? bu1 : bu0; float v[4];
#pragma unroll
                    for (int j = 0; j < 4; ++j) { float g = acc[ai][0][m][n][j] * W8_INV + bg[j], uu = acc[ai][1][m][n][j] * W8_INV + bu[j];
                        g = fminf(g, SW_LIM); uu = fminf(fmaxf(uu, -SW_LIM), SW_LIM); v[j] = g * fsig(SW_ALPHA * g) * (uu + 1.0f); }
                    w[n] = __builtin_amdgcn_cvt_pk_fp8_f32(v[0], v[1], w[n], false); w[n] = __builtin_amdgcn_cvt_pk_fp8_f32(v[2], v[3], w[n], true); }
                *(uint2*)(O + (size_t)(row0 + ai * HALF + m * 16) * FF + ffc0) = make_uint2((unsigned)w[0], (unsigned)w[1]); }
    }
};
struct EpiDownMk {
    static constexpr bool PERM = true, AFTER_DRAIN = false, INIT_ACC = false;
    bf16_t* O; const float* bias;
    DI void operator()(const f32x4 (&acc)[2][2][4][2], const Unit& u, int wr, int wc, int fr, int fq) const {
        const int e = u.pn >> 2, ct = u.pn & 3, row0 = u.pm * BM + wr * 64 + fr, col0 = ct * BM + wc * 32 + 8 * fq;
        const float* bp = bias + (size_t)e * D + col0; const f32x4 q0 = *(const f32x4*)bp, q1 = *(const f32x4*)(bp + 4), q2 = *(const f32x4*)(bp + HALF), q3 = *(const f32x4*)(bp + HALF + 4);
#pragma unroll
        for (int bj = 0; bj < 2; ++bj) { float b[8];
#pragma unroll
            for (int j = 0; j < 8; ++j) b[j] = bj ? (j < 4 ? q2[j & 3] : q3[j & 3]) : (j < 4 ? q0[j & 3] : q1[j & 3]);
#pragma unroll
            for (int ai = 0; ai < 2; ++ai)
#pragma unroll
                for (int m = 0; m < 4; ++m) { float v[8];
#pragma unroll
                    for (int j = 0; j < 8; ++j) v[j] = acc[ai][bj][m][j >> 2][j & 3] * W8_INV + b[j];
                    u32x4 w; w.x = cvt_pk_bf16(v[0], v[1]); w.y = cvt_pk_bf16(v[2], v[3]); w.z = cvt_pk_bf16(v[4], v[5]); w.w = cvt_pk_bf16(v[6], v[7]);
                    *(u32x4*)(O + (size_t)(row0 + ai * HALF + m * 16) * D + col0 + bj * HALF) = w; } }
    }
};
template <bool GATHER_> struct MoeOrder {
    static constexpr bool GATHER = GATHER_;
    const volatile PG8_LAS int* meta; int NCT, G, c; const int* elist;
    DI bool next(int i, Unit& u) const {
        const int nwg = __builtin_amdgcn_readfirstlane(meta[32]); const long L = (long)i * G + c; if (L >= nwg) return false;
        int wgid = (int)L; { const int q = nwg / NXCD, r = nwg % NXCD, xcd = wgid % NXCD, off = wgid / NXCD; wgid = (xcd < r ? xcd * (q + 1) : r * (q + 1) + (xcd - r) * q) + off; }
        const int ln_ = threadIdx.x & 63, pv_ = meta[ln_ & 31];
        const int e = (int)__popcll(__ballot(ln_ >= 1 && ln_ < 32 && pv_ <= wgid));
        const int local = wgid - __builtin_amdgcn_readfirstlane(meta[e]), nt = __builtin_amdgcn_readfirstlane(meta[80 + e]), rt = local % nt, ct = local / nt;
        u.pm = __builtin_amdgcn_readfirstlane(meta[40 + e]) + rt; u.pn = e * NCT + ct; u.e = e; u.r0 = rt * 256; u.cnt = __builtin_amdgcn_readfirstlane(meta[120 + e]); return true;
    }
    DI void gather_issue(const Unit& u, int tid, int (&tok)[2][2]) const {
#pragma unroll
        for (int i = 0; i < 2; ++i) { int R, C; stage_rc(tid * 16 + i * 8192, R, C);
#pragma unroll
            for (int h = 0; h < 2; ++h) { const int slot = u.r0 + h * HALF + R; tok[h][i] = slot < u.cnt ? elist[(size_t)u.e * 16384 + slot] : 0; } }
    }
    DI void gather_finish(const int (&tok)[2][2], int K, int tid, unsigned (&out)[2][2]) const {
#pragma unroll
        for (int i = 0; i < 2; ++i) { int R, C; stage_rc(tid * 16 + i * 8192, R, C);
#pragma unroll
            for (int h = 0; h < 2; ++h) out[h][i] = (unsigned)(tok[h][i] * K + C) * 2u; }
    }
    DI void gather_voffs(const Unit& u, int K, int tid, unsigned (&out)[2][2]) const {
#pragma unroll
        for (int i = 0; i < 2; ++i) { int R, C; stage_rc(tid * 16 + i * 8192, R, C);
#pragma unroll
            for (int h = 0; h < 2; ++h) { const int slot = u.r0 + h * HALF + R; const int tok = slot < u.cnt ? elist[(size_t)u.e * 16384 + slot] : 0; out[h][i] = (unsigned)(tok * K + C) * 2u; } }
    }
    DI void a_ready(const Unit&) const {}
    DI void done(const Unit&) const {}
};
}

constexpr int NWAVES = 8, NTHREADS = 512;
constexpr int PROBE_LO = -1, PROBE_HI = -1;
constexpr int RING_BYTES = 131072, LDSCTL_OFF = 135168, META_OFF = LDSCTL_OFF + 512, SS_OFF = LDSCTL_OFF + 2048, LDS_BYTES = 147456;
static_assert(META_OFF + 152 * 4 <= SS_OFF && SS_OFF + 1024 + 64 * 33 * 4 <= LDS_BYTES, "LDS control map");
#define LAS __attribute__((address_space(3)))
#define GAS __attribute__((address_space(1)))
typedef unsigned v4u __attribute__((ext_vector_type(4)));
typedef float f32x4 __attribute__((ext_vector_type(4)));
DI unsigned pk2(float lo, float hi) { return (unsigned)f2bf(lo) | ((unsigned)f2bf(hi) << 16); }

typedef short bf16x8 __attribute__((ext_vector_type(8)));
typedef short bf16x4 __attribute__((ext_vector_type(4)));
typedef float f32x2_t __attribute__((ext_vector_type(2)));
typedef __bf16 bf16x2_t __attribute__((ext_vector_type(2)));
#define MFMA16(a, b, c) __builtin_amdgcn_mfma_f32_16x16x32_bf16((a), (b), (c), 0, 0, 0)
constexpr float LOG2E = 1.4426950408889634f;
DI unsigned cvtpk(float lo, float hi) { f32x2_t v = {lo, hi}; bf16x2_t b = __builtin_convertvector(v, bf16x2_t); return __builtin_bit_cast(unsigned, b); }
DI bf16x8 pack_ab(const f32x4& a, const f32x4& b) { v4u w; w.x = cvtpk(a[0], a[1]); w.y = cvtpk(a[2], a[3]); w.z = cvtpk(b[0], b[1]); w.w = cvtpk(b[2], b[3]); return __builtin_bit_cast(bf16x8, w); }
DI bf16x8 cat44(bf16x4 lo, bf16x4 hi) { return __builtin_shufflevector(lo, hi, 0, 1, 2, 3, 4, 5, 6, 7); }


struct HgConst { bf16x8 F0, F1, I0, I1, ONES; };
DI HgConst hg_make_const(int lane, int dir) {
    const int c = lane & 15, g = lane >> 4; HgConst K;
#pragma unroll
    for (int j = 0; j < 8; ++j) { const int sp = 8 * g + j;
        K.F0[j] = (dir ? (sp >= c) : (sp <= c)) ? (short)0x3F80 : (short)0; K.F1[j] = (dir ? (sp >= 16 + c) : (sp <= 16 + c)) ? (short)0x3F80 : (short)0;
        K.I0[j] = (sp == c) ? (short)0x3F80 : (short)0; K.I1[j] = (sp == 16 + c) ? (short)0x3F80 : (short)0; K.ONES[j] = (short)0x3F80; }
    return K;
}
DI float fexp(float x) { return __builtin_amdgcn_exp2f(x * LOG2E); }
DI unsigned pk4_fp8(float a, float b, float c, float d) { int w = 0; w = __builtin_amdgcn_cvt_pk_fp8_f32(a, b, w, false); w = __builtin_amdgcn_cvt_pk_fp8_f32(c, d, w, true); return (unsigned)w; }
DI bf16x8 fp8x8_to_bf16(uint2 u) { const f32x2_t a = __builtin_amdgcn_cvt_pk_f32_fp8((int)u.x, false), b = __builtin_amdgcn_cvt_pk_f32_fp8((int)u.x, true), c = __builtin_amdgcn_cvt_pk_f32_fp8((int)u.y, false), d = __builtin_amdgcn_cvt_pk_f32_fp8((int)u.y, true);
    v4u w; w.x = cvtpk(a[0], a[1]); w.y = cvtpk(b[0], b[1]); w.z = cvtpk(c[0], c[1]); w.w = cvtpk(d[0], d[1]); return __builtin_bit_cast(bf16x8, w); }
constexpr f32x4 Z4 = {0.f, 0.f, 0.f, 0.f};
DI void hg_pass1(const bf16* __restrict__ PT, unsigned char* __restrict__ U, float* __restrict__ DEC, int uid, int lane, const HgConst& K, int dir) {
    const int c = lane & 15, g = lane >> 4, n = (uid >> 1) & 127, h = (uid >> 8) & 7, b = uid >> 11;
    const size_t tok0 = (size_t)b * SEQ + n * CH;
    const bf16* gp = PT + ptb_blk((dir ? R_GB : R_GF) + h * 128, (int)tok0) + lane * 8;
    const bf16* vp = PT + ptb_blk(R_V + h * 128, (int)tok0) + lane * 8;
    bf16x8 vB[8][2];
#pragma unroll
    for (int dvt = 0; dvt < 8; ++dvt)
#pragma unroll
        for (int ks = 0; ks < 2; ++ks) vB[dvt][ks] = *(const bf16x8*)(vp + (size_t)dvt * (T / 32) * 512 + ks * 512);
    unsigned char* up = U + (size_t)uid * 16384 + lane * 8;
#define P1_LOADG(dst_, dt_) do { _Pragma("unroll") for (int ks = 0; ks < 2; ++ks) dst_[ks] = *(const bf16x8*)(gp + (size_t)(dt_) * (T / 32) * 512 + ks * 512); } while (0)
#define P1_KEND(gB, dt, kA0, kA1) do { \
        f32x4 tot = MFMA16(K.ONES, gB[0], Z4); tot = MFMA16(K.ONES, gB[1], tot); \
        f32x4 ke[4]; \
        _Pragma("unroll") for (int tt = 0; tt < 4; ++tt) { \
            f32x4 cum = MFMA16((tt & 1) ? K.F1 : K.F0, gB[tt >> 1], Z4); \
            if (!dir && tt >= 2) cum = MFMA16(K.ONES, gB[0], cum); \
            if (dir && tt < 2) cum = MFMA16(K.ONES, gB[1], cum); \
            const f32x4 gt = MFMA16((tt & 1) ? K.I1 : K.I0, gB[tt >> 1], Z4); \
            _Pragma("unroll") for (int r = 0; r < 4; ++r) ke[tt][r] = (1.0f - fexp(gt[r])) * fexp(tot[r] - cum[r]); } \
        kA0 = pack_ab(ke[0], ke[1]); kA1 = pack_ab(ke[2], ke[3]); \
        if (g == 0) DEC[(size_t)uid * 128 + (dt) * 16 + c] = fexp(tot[0]); } while (0)
    bf16x8 gBa[2], gBb[2];
    P1_LOADG(gBa, 0); P1_LOADG(gBb, 1);
#pragma unroll 1
    for (int kd = 0; kd < 4; ++kd) {
        bf16x8 a0, a1, b0, b1;
        P1_KEND(gBa, 2 * kd, a0, a1);
        if (kd < 3) P1_LOADG(gBa, 2 * kd + 2);
        P1_KEND(gBb, 2 * kd + 1, b0, b1);
        if (kd < 3) P1_LOADG(gBb, 2 * kd + 3);
#pragma unroll
        for (int dvt = 0; dvt < 8; ++dvt) { f32x4 x = MFMA16(a0, vB[dvt][0], Z4); x = MFMA16(a1, vB[dvt][1], x); f32x4 y = MFMA16(b0, vB[dvt][0], Z4); y = MFMA16(b1, vB[dvt][1], y);
            *(uint2*)(up + (dvt * 4 + kd) * 512) = make_uint2(pk4_fp8(x[0], x[1], x[2], x[3]), pk4_fp8(y[0], y[1], y[2], y[3])); }
    }
#undef P1_LOADG
#undef P1_KEND
}
template <int dir> DI void hg_pass3_a(const bf16* __restrict__ PN, const bf16* __restrict__ PT, const unsigned char* __restrict__ U, int bhn, int lane, const HgConst& K, f32x4 (&keep)[4][4], LAS unsigned char* myslot) {
    const int c = lane & 15, g = lane >> 4, n = bhn & 127, h = (bhn >> 7) & 7, b = bhn >> 10; const int uid = bhn * 2 + dir;
    const size_t tok0 = (size_t)b * SEQ + n * CH;
    const bf16* gp = PT + ptb_blk((dir ? R_GB : R_GF) + h * 128, (int)tok0) + lane * 8;
    const bf16* qp = PN + pn_stripe(tok0) + ((N_Q + h * 128) >> 5) * 512 + lane * 8;
    f32x4 sc[4][4];
#pragma unroll
    for (int st = 0; st < 4; ++st)
#pragma unroll
        for (int tt = 0; tt < 4; ++tt) sc[st][tt] = Z4;
    bf16x8 qdB[4][4];
    bf16x8 gAb[2][2][2], q8b[2][4];
#define P3_LOAD_KD(buf_, kd_) do { _Pragma("unroll") for (int hf = 0; hf < 2; ++hf) _Pragma("unroll") for (int ks = 0; ks < 2; ++ks) gAb[buf_][hf][ks] = *(const bf16x8*)(gp + (size_t)(2 * (kd_) + hf) * (T / 32) * 512 + ks * 512); \
        _Pragma("unroll") for (int tt = 0; tt < 4; ++tt) q8b[buf_][tt] = *(const bf16x8*)(qp + (size_t)tt * 16 * NATW + (kd_) * 512); } while (0)
    P3_LOAD_KD(0, 0);
#pragma unroll
    for (int kd = 0; kd < 4; ++kd) {
        bf16x8 kiA[4];
        if (kd < 3) P3_LOAD_KD((kd + 1) & 1, kd + 1);
#pragma unroll
        for (int tt = 0; tt < 4; ++tt) {
            f32x4 qd[2], ki[2]; const bf16x8 q8 = q8b[kd & 1][tt];
#pragma unroll
            for (int hf = 0; hf < 2; ++hf) {
                f32x4 cum = MFMA16(gAb[kd & 1][hf][tt >> 1], (tt & 1) ? K.F1 : K.F0, Z4);
                if (!dir && tt >= 2) cum = MFMA16(gAb[kd & 1][hf][0], K.ONES, cum);
                if (dir && tt < 2) cum = MFMA16(gAb[kd & 1][hf][1], K.ONES, cum);
                const f32x4 gt = MFMA16(gAb[kd & 1][hf][tt >> 1], (tt & 1) ? K.I1 : K.I0, Z4);
#pragma unroll
                for (int r = 0; r < 4; ++r) { qd[hf][r] = bf2f((bf16)q8[hf * 4 + r]) * fexp(cum[r]); ki[hf][r] = (1.0f - fexp(gt[r])) * fexp(-cum[r]); }
            }
            qdB[tt][kd] = pack_ab(qd[0], qd[1]); kiA[tt] = pack_ab(ki[0], ki[1]);
        }
#pragma unroll
        for (int st = 0; st < 4; ++st)
#pragma unroll
            for (int tt = 0; tt < 4; ++tt) if (dir ? (st >= tt) : (st <= tt)) sc[st][tt] = MFMA16(kiA[st], qdB[tt][kd], sc[st][tt]);
        asm volatile("" ::: "memory");
    }
#undef P3_LOAD_KD
    bf16x8 sB[4][2];
#pragma unroll
    for (int tt = 0; tt < 4; ++tt) {
#pragma unroll
        for (int st = 0; st < 4; ++st)
#pragma unroll
            for (int r = 0; r < 4; ++r) { const int s_ = 16 * st + 4 * g + r, t_ = 16 * tt + c; const bool kp = dir ? (s_ >= t_) : (s_ <= t_); sc[st][tt][r] = kp ? sc[st][tt][r] : 0.f; }
        sB[tt][0] = pack_ab(sc[0][tt], sc[1][tt]); sB[tt][1] = pack_ab(sc[2][tt], sc[3][tt]);
    }
    const bf16* vp = PT + ptb_blk(R_V + h * 128, (int)tok0) + lane * 8;
    const unsigned char* sp = U + (size_t)uid * 16384 + lane * 8;
    bf16x8 vAb[2][2]; uint2 sAr[2][4];
#define P3_LOAD_DV(buf_, dvt_) do { _Pragma("unroll") for (int k2 = 0; k2 < 2; ++k2) vAb[buf_][k2] = *(const bf16x8*)(vp + (size_t)(dvt_) * (T / 32) * 512 + k2 * 512); \
        _Pragma("unroll") for (int kd = 0; kd < 4; ++kd) sAr[buf_][kd] = *(const uint2*)(sp + ((dvt_) * 4 + kd) * 512); } while (0)
    P3_LOAD_DV(0, 0);
#pragma unroll
    for (int dvt = 0; dvt < 8; ++dvt) {
        if (dvt < 7) P3_LOAD_DV((dvt + 1) & 1, dvt + 1);
        bf16x8 sA[4];
#pragma unroll
        for (int kd = 0; kd < 4; ++kd) sA[kd] = fp8x8_to_bf16(sAr[dvt & 1][kd]);
#pragma unroll
        for (int tt = 0; tt < 4; ++tt) {
            f32x4 acc = MFMA16(vAb[dvt & 1][0], sB[tt][0], Z4); acc = MFMA16(vAb[dvt & 1][1], sB[tt][1], acc);
#pragma unroll
            for (int kd = 0; kd < 4; ++kd) acc = MFMA16(sA[kd], qdB[tt][kd], acc);
            if ((dvt >> 2) == dir) keep[dvt & 3][tt] = acc;
            else *(LAS f32x4*)(myslot + ((dvt & 3) * 4 + tt) * 1024 + lane * 16) = acc;
        }
        asm volatile("" ::: "memory");
    }
#undef P3_LOAD_DV
}
DI void hg_pass3_b(int lane, f32x4 (&keep)[4][4], const LAS unsigned char* oslot, LAS float* myss) {
#pragma unroll
    for (int tt = 0; tt < 4; ++tt) { float ss = 0.f;
#pragma unroll
        for (int dq = 0; dq < 4; ++dq) { keep[dq][tt] = keep[dq][tt] + *(const LAS f32x4*)(oslot + (dq * 4 + tt) * 1024 + lane * 16);
            const f32x4 o = keep[dq][tt]; ss += (o[0] * o[0] + o[1] * o[1]) + (o[2] * o[2] + o[3] * o[3]); }
        ss += __shfl_xor(ss, 16); ss += __shfl_xor(ss, 32);
        myss[tt * 64 + lane] = ss; }
}
DI void hg_pass3_c(const bf16* __restrict__ PN, const bf16* __restrict__ YA, const float* __restrict__ gng, bf16* __restrict__ MG, int bhn, int lane, int dir, const f32x4 (&keep)[4][4], const LAS float* myss, const LAS float* oss) {
    const int c = lane & 15, g = lane >> 4, n = bhn & 127, h = (bhn >> 7) & 7, b = bhn >> 10;
    const size_t tok0 = (size_t)b * SEQ + n * CH;
#pragma unroll
    for (int tt = 0; tt < 4; ++tt) { const float rstd = rsqrtf((myss[tt * 64 + lane] + oss[tt * 64 + lane]) * (1.0f / 128.0f) + EPS);
        const size_t tok = tok0 + 16 * tt + c;
#pragma unroll
        for (int dq = 0; dq < 4; ++dq) { const int dvl = 64 * dir + 16 * dq + 4 * g, col = h * 128 + dvl;
            const bf16x4 sg = *(const bf16x4*)(PN + pn_stripe(tok) + ((N_G + col) >> 4) * 256 + lane * 4), ga = *(const bf16x4*)(PN + pn_stripe(tok) + ((N_GA + col) >> 4) * 256 + lane * 4), ya = *(const bf16x4*)(YA + ya_stripe(tok) + (col >> 4) * 256 + lane * 4);
            const f32x4 gn = *(const f32x4*)(gng + dvl); const f32x4 o = keep[dq][tt]; float m[4];
#pragma unroll
            for (int r = 0; r < 4; ++r) m[r] = bf2f((bf16)ga[r]) * (o[r] * rstd * gn[r] * bf2f((bf16)sg[r])) + bf2f((bf16)ya[r]);
            uint2 w; w.x = cvtpk(m[0], m[1]); w.y = cvtpk(m[2], m[3]); *(uint2*)(MG + tok * D + col) = w; } }
}
DI void attn_unit(const bf16* __restrict__ PN, const bf16* __restrict__ PT, const float* __restrict__ sink, bf16* __restrict__ YA, int b, int kv, int qt, int hh, int lane) {
    const int c = lane & 15, g = lane >> 4, q0 = qt * 16, t = q0 + c;
    const size_t tok = (size_t)b * SEQ + t;
    bf16x8 qf[2][2];
#pragma unroll
    for (int nt = 0; nt < 2; ++nt)
#pragma unroll
        for (int ks = 0; ks < 2; ++ks) qf[nt][ks] = *(const bf16x8*)(PN + pn_stripe(tok) + ((N_AQ + (kv * 4 + hh * 2 + nt) * 64) >> 5) * 512 + ks * 512 + lane * 8);
    float slope[2], mrun[2], lrun[2];
#pragma unroll
    for (int nt = 0; nt < 2; ++nt) { const int h = kv * 4 + hh * 2 + nt; slope[nt] = exp2f(-0.5f * (float)(h + 1)) * LOG2E; mrun[nt] = sink[h] * LOG2E; lrun[nt] = (g == 0) ? 1.0f : 0.0f; }
    f32x4 O[4][2];
#pragma unroll
    for (int mt = 0; mt < 4; ++mt)
#pragma unroll
        for (int nt = 0; nt < 2; ++nt) O[mt][nt] = (f32x4){0.f, 0.f, 0.f, 0.f};
    const bf16* Kbase = PN + (size_t)b * SEQ * NATW + ((N_AK + kv * 64) >> 5) * 512 + lane * 8;
    const bf16* Vbase = PT + ptb_blk(R_AV + kv * 64, b * SEQ) + c * 8;
    const int sb0 = q0 - WIN;
    bf16x8 kf[2][2];
#define ATT_LOADK(sb_) do { _Pragma("unroll") for (int ab = 0; ab < 2; ++ab) { int s_ = (sb_) + 16 * ab; s_ = (s_ < 0 || s_ >= SEQ) ? 0 : s_; \
        _Pragma("unroll") for (int ks = 0; ks < 2; ++ks) kf[ab][ks] = *(const bf16x8*)(Kbase + (size_t)(s_ >> 4) * 16 * NATW + ks * 512); } } while (0)
    ATT_LOADK(sb0);
#pragma unroll 1
    for (int i = 0; i < 9; ++i) {
        const int sb = sb0 + 32 * i;
        bf16x8 vf[4];
#pragma unroll
        for (int mt = 0; mt < 4; ++mt) { bf16x4 lo, hi;
            { int s4 = sb + 4 * g; s4 = (s4 >= 0 && s4 < SEQ) ? s4 : 0; lo = *(const bf16x4*)(Vbase + (size_t)mt * (T / 32) * 512 + (s4 >> 5) * 512 + ((s4 & 15) >> 2) * 128 + ((s4 >> 4) & 1) * 4); }
            { int s4 = sb + 16 + 4 * g; s4 = (s4 >= 0 && s4 < SEQ) ? s4 : 0; hi = *(const bf16x4*)(Vbase + (size_t)mt * (T / 32) * 512 + (s4 >> 5) * 512 + ((s4 & 15) >> 2) * 128 + ((s4 >> 4) & 1) * 4); }
            vf[mt] = cat44(lo, hi); }
        f32x4 Sa[2], Sb[2];
#pragma unroll
        for (int nt = 0; nt < 2; ++nt) { Sa[nt] = (f32x4){0.f, 0.f, 0.f, 0.f}; Sb[nt] = (f32x4){0.f, 0.f, 0.f, 0.f};
#pragma unroll
            for (int ks = 0; ks < 2; ++ks) { Sa[nt] = MFMA16(kf[0][ks], qf[nt][ks], Sa[nt]); Sb[nt] = MFMA16(kf[1][ks], qf[nt][ks], Sb[nt]); } }
        if (i < 8) ATT_LOADK(sb + 32);
        const int rel0 = t - (sb + 4 * g);
        bf16x8 pb[2];
        const bool interior = (i >= 1) && (i <= 7) && (sb >= 0) && (sb + 32 <= SEQ);
        const float rel0f = (float)rel0;
#pragma unroll
        for (int nt = 0; nt < 2; ++nt) {
            float va[4], vb[4]; float vmax = -INFINITY;
            if (interior) {
#pragma unroll
                for (int r = 0; r < 4; ++r) { va[r] = Sa[nt][r] - slope[nt] * fabsf(rel0f - (float)r); vb[r] = Sb[nt][r] - slope[nt] * fabsf(rel0f - (float)(16 + r)); vmax = fmaxf(vmax, fmaxf(va[r], vb[r])); }
            } else {
#pragma unroll
                for (int r = 0; r < 4; ++r) {
                    const int ra = rel0 - r, rb = rel0 - 16 - r; const int sa = t - ra, sbb = t - rb;
                    const bool oka = (ra <= WIN) && (ra >= -WIN) && (sa >= 0) && (sa < SEQ), okb = (rb <= WIN) && (rb >= -WIN) && (sbb >= 0) && (sbb < SEQ);
                    va[r] = oka ? Sa[nt][r] - slope[nt] * fabsf((float)ra) : -INFINITY; vb[r] = okb ? Sb[nt][r] - slope[nt] * fabsf((float)rb) : -INFINITY;
                    vmax = fmaxf(vmax, fmaxf(va[r], vb[r])); }
            }
            vmax = fmaxf(vmax, __shfl_xor(vmax, 16)); vmax = fmaxf(vmax, __shfl_xor(vmax, 32));
            const float mnew = fmaxf(mrun[nt], vmax), alpha = __builtin_amdgcn_exp2f(mrun[nt] - mnew);
            const bool moved = __any(mnew != mrun[nt]); mrun[nt] = mnew;
            f32x4 pa, pbv; float ps = 0.f;
#pragma unroll
            for (int r = 0; r < 4; ++r) { pa[r] = __builtin_amdgcn_exp2f(va[r] - mnew); pbv[r] = __builtin_amdgcn_exp2f(vb[r] - mnew); ps += pa[r] + pbv[r]; }
            lrun[nt] = lrun[nt] * alpha + ps;
            if (moved) {
#pragma unroll
                for (int mt = 0; mt < 4; ++mt) O[mt][nt] = O[mt][nt] * alpha; }
            pb[nt] = pack_ab(pa, pbv);
        }
#pragma unroll
        for (int mt = 0; mt < 4; ++mt)
#pragma unroll
            for (int nt = 0; nt < 2; ++nt) O[mt][nt] = MFMA16(vf[mt], pb[nt], O[mt][nt]);
    }
#undef ATT_LOADK
#pragma unroll
    for (int nt = 0; nt < 2; ++nt) { const int h = kv * 4 + hh * 2 + nt;
        float l = lrun[nt]; l += __shfl_xor(l, 16); l += __shfl_xor(l, 32); const float inv = 1.0f / l;
#pragma unroll
        for (int mt = 0; mt < 4; ++mt) { const int col = h * 64 + 16 * mt + 4 * g;
            const bf16x4 gt = *(const bf16x4*)(PN + pn_stripe(tok) + ((N_GB + col) >> 4) * 256 + lane * 4);
            const f32x4 o = O[mt][nt] * inv;
            uint2 w; w.x = cvtpk(o[0] * bf2f((bf16)gt[0]), o[1] * bf2f((bf16)gt[1])); w.y = cvtpk(o[2] * bf2f((bf16)gt[2]), o[3] * bf2f((bf16)gt[3]));
            *(uint2*)(YA + ya_stripe(tok) + (col >> 4) * 256 + lane * 4) = w; } }
}

DI void transpose_item(const float* W, int N, int K, int k0, int in_col0, bf16* WT, int out_row0, LAS float* scr, int lane) {
    float tmp_[32];
#pragma unroll
    for (int i = 0; i < 32; ++i) { const int kk = 2 * i + (lane >> 5); tmp_[i] = W[(size_t)(k0 + kk) * N + in_col0 + (lane & 31)]; }
#pragma unroll
    for (int i = 0; i < 32; ++i) { const int kk = 2 * i + (lane >> 5); scr[kk * 33 + (lane & 31)] = tmp_[i]; }
    asm volatile("s_waitcnt lgkmcnt(0)" ::: "memory");
    const int c = lane & 7;
#pragma unroll
    for (int j = 0; j < 4; ++j) { const int n = (lane >> 3) + 8 * j; const LAS float* s = scr + (8 * c) * 33 + n;
        v4u o; o.x = pk2(s[0 * 33], s[1 * 33]); o.y = pk2(s[2 * 33], s[3 * 33]); o.z = pk2(s[4 * 33], s[5 * 33]); o.w = pk2(s[6 * 33], s[7 * 33]);
        *(v4u*)(WT + (size_t)(out_row0 + n) * K + k0 + 8 * c) = o; }
    asm volatile("s_waitcnt lgkmcnt(0)" ::: "memory");
}


DI void transpose_item8(const float* W, int N, int K, int k0, int in_col0, unsigned char* WT, int out_row0, LAS float* scr, int lane) {
    float tmp_[32];
#pragma unroll
    for (int i = 0; i < 32; ++i) { const int kk = 2 * i + (lane >> 5); tmp_[i] = W[(size_t)(k0 + kk) * N + in_col0 + (lane & 31)]; }
#pragma unroll
    for (int i = 0; i < 32; ++i) { const int kk = 2 * i + (lane >> 5); scr[kk * 33 + (lane & 31)] = tmp_[i]; }
    asm volatile("s_waitcnt lgkmcnt(0)" ::: "memory");
    const int c = lane & 7;
#pragma unroll
    for (int j = 0; j < 4; ++j) { const int n = (lane >> 3) + 8 * j; const LAS float* s = scr + (8 * c) * 33 + n;
        int w0 = 0, w1 = 0;
        w0 = __builtin_amdgcn_cvt_pk_fp8_f32(s[0 * 33] * W8_SCALE, s[1 * 33] * W8_SCALE, w0, false); w0 = __builtin_amdgcn_cvt_pk_fp8_f32(s[2 * 33] * W8_SCALE, s[3 * 33] * W8_SCALE, w0, true);
        w1 = __builtin_amdgcn_cvt_pk_fp8_f32(s[4 * 33] * W8_SCALE, s[5 * 33] * W8_SCALE, w1, false); w1 = __builtin_amdgcn_cvt_pk_fp8_f32(s[6 * 33] * W8_SCALE, s[7 * 33] * W8_SCALE, w1, true);
        *(uint2*)(WT + (size_t)(out_row0 + n) * K + k0 + 8 * c) = make_uint2((unsigned)w0, (unsigned)w1); }
    asm volatile("s_waitcnt lgkmcnt(0)" ::: "memory");
}


DI void conv_issue(const float* src, int N, int lane, float (&tmp)[32]) {
    const unsigned long long a = (unsigned long long)src;
    const float* su = (const float*)(((unsigned long long)(unsigned)__builtin_amdgcn_readfirstlane((int)(a >> 32)) << 32) | (unsigned)__builtin_amdgcn_readfirstlane((int)a));
    const int Nu = __builtin_amdgcn_readfirstlane(N);
    const __amdgpu_buffer_rsrc_t rs = __builtin_amdgcn_make_buffer_rsrc((void*)su, (short)0, 64 * Nu * 4, 0x00020000);
    const int voff = ((lane >> 3) * Nu + (lane & 7) * 4) * 4;
#pragma unroll
    for (int i = 0; i < 8; ++i) { const v4u q = __builtin_amdgcn_raw_buffer_load_b128(rs, voff, 8 * i * Nu * 4, 2);
        tmp[4 * i] = __uint_as_float(q.x); tmp[4 * i + 1] = __uint_as_float(q.y); tmp[4 * i + 2] = __uint_as_float(q.z); tmp[4 * i + 3] = __uint_as_float(q.w); }
}
DI void conv_finish(const float (&tmp)[32], unsigned char* dst, int K, LAS float* scr, int lane) {
#pragma unroll
    for (int i = 0; i < 8; ++i) { const int kk = 8 * i + (lane >> 3), n4 = (lane & 7) * 4;
#pragma unroll
        for (int c = 0; c < 4; ++c) scr[kk * 33 + n4 + c] = tmp[4 * i + c]; }
    asm volatile("s_waitcnt lgkmcnt(0)" ::: "memory");
    const int c = lane & 7;
#pragma unroll
    for (int j = 0; j < 4; ++j) { const int n = (lane >> 3) + 8 * j; const LAS float* s = scr + (8 * c) * 33 + n;
        int w0 = 0, w1 = 0;
        w0 = __builtin_amdgcn_cvt_pk_fp8_f32(s[0 * 33] * W8_SCALE, s[1 * 33] * W8_SCALE, w0, false); w0 = __builtin_amdgcn_cvt_pk_fp8_f32(s[2 * 33] * W8_SCALE, s[3 * 33] * W8_SCALE, w0, true);
        w1 = __builtin_amdgcn_cvt_pk_fp8_f32(s[4 * 33] * W8_SCALE, s[5 * 33] * W8_SCALE, w1, false); w1 = __builtin_amdgcn_cvt_pk_fp8_f32(s[6 * 33] * W8_SCALE, s[7 * 33] * W8_SCALE, w1, true);
        { typedef unsigned u32x2_ __attribute__((ext_vector_type(2))); const u32x2_ o2 = {(unsigned)w0, (unsigned)w1}; __builtin_nontemporal_store(o2, (u32x2_*)(dst + (size_t)n * K + 8 * c)); } }
    asm volatile("s_waitcnt lgkmcnt(0)" ::: "memory");
}
DI void moe_item_desc(int r, const float* w_ug, const float* w_d, unsigned char* WUG, unsigned char* WD, const float*& src, int& N, unsigned char*& dst) {
    constexpr int I_UG = NE * 16 * 64;
    if (r < I_UG) { const int e = r / (16 * 64), q = r % (16 * 64), kb = q / 64, nb = q % 64; N = 2048;
        src = w_ug + (size_t)e * D * 2048 + (size_t)(kb * 64) * 2048 + wug_row_to_col(nb * 32); dst = WUG + (size_t)e * 2048 * D + (size_t)(nb * 32) * D + kb * 64; }
    else { r -= I_UG; const int e = r / (16 * 32), q = r % (16 * 32), kb = q / 32, nb = q % 32; N = D;
        src = w_d + (size_t)e * D * D + (size_t)(kb * 64) * D + nb * 32; dst = WD + (size_t)e * D * D + (size_t)(nb * 32) * D + kb * 64; }
}

DI void conv_batch4(int cit, int stride, const float* w_ug, const float* w_d, unsigned char* WUG, unsigned char* WD, LAS float* scr, int lane) {
    float t0[32], t1[32], t2[32], t3[32]; const float *s0, *s1, *s2, *s3; unsigned char *d0, *d1, *d2, *d3; int n0, n1, n2, n3;
    moe_item_desc(cit, w_ug, w_d, WUG, WD, s0, n0, d0); conv_issue(s0, n0, lane, t0);
    moe_item_desc(cit + stride, w_ug, w_d, WUG, WD, s1, n1, d1); conv_issue(s1, n1, lane, t1);
    moe_item_desc(cit + 2 * stride, w_ug, w_d, WUG, WD, s2, n2, d2); conv_issue(s2, n2, lane, t2);
    moe_item_desc(cit + 3 * stride, w_ug, w_d, WUG, WD, s3, n3, d3); conv_issue(s3, n3, lane, t3);
    conv_finish(t0, d0, D, scr, lane); conv_finish(t1, d1, D, scr, lane); conv_finish(t2, d2, D, scr, lane); conv_finish(t3, d3, D, scr, lane);
}

#define XB_TMO      128
#define XB_XCNT(j)  (256  + 64 * (j))
#define XB_XSUB(j)  (1280 + 64 * (j))
#define XB_XGEN(j)  (2304 + 64 * (j))
#define XB_TOP      3328
#define XB_TOPGEN   3392
#define XCD_BAR_WORDS 3456
#define XB_SPIN_CAP (1u << 18)

__device__ __forceinline__ unsigned xb_ld(unsigned* p)              { return __hip_atomic_load(p, __ATOMIC_RELAXED, __HIP_MEMORY_SCOPE_AGENT); }
__device__ __forceinline__ unsigned xb_add(unsigned* p, unsigned v) { return __hip_atomic_fetch_add(p, v, __ATOMIC_RELAXED, __HIP_MEMORY_SCOPE_AGENT); }
__device__ __forceinline__ unsigned xb_xcc_id() { return (unsigned)__builtin_amdgcn_s_getreg((3 << 11) | 20) & 0xFu; }
#define XB_SPIN(cond, bar) do { unsigned _sp = 0; while (cond) { __builtin_amdgcn_s_sleep(1); \
    if ((++_sp & 255u) == 0u) { if (xb_ld(&(bar)[XB_TMO])) break; if (_sp > XB_SPIN_CAP) { atomicAdd(&(bar)[XB_TMO], 1u); break; } } } } while (0)

struct XcdBarrier {
    unsigned* bar; unsigned x;
    volatile LAS unsigned* st;
};

__device__ __forceinline__ XcdBarrier xcd_barrier_post(unsigned* bar, volatile LAS unsigned* st) {
    XcdBarrier b; b.bar = bar; b.x = xb_xcc_id(); b.st = st;
    if (threadIdx.x == 0) (void)xb_add(&bar[XB_XCNT(b.x)], 1u);
    return b;
}
__device__ __forceinline__ void xcd_barrier_complete(unsigned* bar, unsigned x, unsigned& nloc, unsigned& nx) {
    const unsigned G = gridDim.x * gridDim.y * gridDim.z;
    unsigned sum, cnt, mine, sp = 0u;
    for (;;) {
        sum = 0u; cnt = 0u; mine = 0u;
#pragma unroll
        for (unsigned j = 0; j < 16; ++j) { const unsigned c = xb_ld(&bar[XB_XCNT(j)]); sum += c; cnt += (c > 0u) ? 1u : 0u; mine = (j == x) ? c : mine; }
        if (sum == G) break;
        __builtin_amdgcn_s_sleep(1);
        if ((++sp & 255u) == 0u) { if (xb_ld(&bar[XB_TMO])) break; if (sp > XB_SPIN_CAP) { atomicAdd(&bar[XB_TMO], 1u); break; } }
    }
    nloc = mine > 0u ? mine : 1u; nx = cnt > 0u ? cnt : 1u;
}

__device__ __forceinline__ void xcd_barrier(const XcdBarrier& b) {
    asm volatile("s_waitcnt vmcnt(0)" ::: "memory");
    __syncthreads();
    if (threadIdx.x == 0) {
        unsigned* bar = b.bar;
        __builtin_amdgcn_s_waitcnt(0);
        unsigned nloc = b.st[0], nx = b.st[1];
        if (nloc == 0u) { xcd_barrier_complete(bar, b.x, nloc, nx); b.st[0] = nloc; b.st[1] = nx; }
        const unsigned old = xb_add(&bar[XB_XSUB(b.x)], 1u);
        const unsigned gen = old / nloc;
        if (old + 1u == (gen + 1u) * nloc) {
            __builtin_amdgcn_fence(__ATOMIC_RELEASE, "agent");
            asm volatile("s_waitcnt vmcnt(0)" ::: "memory");
            const unsigned og = xb_add(&bar[XB_TOP], 1u);
            const unsigned tg = og / nx;
            if (og + 1u == (tg + 1u) * nx) xb_add(&bar[XB_TOPGEN], 1u);
            else XB_SPIN(xb_ld(&bar[XB_TOPGEN]) == tg, bar);
            __builtin_amdgcn_fence(__ATOMIC_ACQUIRE, "agent");
            xb_add(&bar[XB_XGEN(b.x)], 1u);
            asm volatile("s_waitcnt vmcnt(0)" ::: "memory");
        } else {
            XB_SPIN(xb_ld(&bar[XB_XGEN(b.x)]) == gen, bar);
            __builtin_amdgcn_fence(__ATOMIC_ACQUIRE, "agent");
            asm volatile("s_waitcnt vmcnt(0)" ::: "memory");
        }
    }
    __syncthreads();
}

struct Args { const float* in[16]; float* out; unsigned char* ws; int ph_lo, ph_hi, li, pad; };
__global__ void __launch_bounds__(NTHREADS, 2) mk_fwd(Args args) {
    extern __shared__ __attribute__((aligned(16))) unsigned char lds[];
    LAS unsigned char* L = (LAS unsigned char*)lds;
    const int tid = threadIdx.x, lane = tid & 63, wave = __builtin_amdgcn_readfirstlane(tid >> 6), G = gridDim.x, bx = blockIdx.x;
    const int vcu = (G % 8 == 0) ? (bx % 8) * (G / 8) + bx / 8 : bx;
    const int gw = vcu * NWAVES + wave, NGW = G * NWAVES;
    unsigned char* ws = args.ws;
    const float* x = args.in[0]; const float* g_mix = args.in[1]; const float* w_in = args.in[2]; const float* lbf = args.in[3]; const float* lbb = args.in[4];
    const float* w_out = args.in[7]; const float* w_ug = args.in[11]; const float* b_ug = args.in[12]; const float* w_d = args.in[13]; const float* b_d = args.in[14];
    unsigned* ctl = (unsigned*)(ws + WS_CTL);
    unsigned char *WUG = ws + WS_WUG, *WD = ws + WS_WD, *ACT = ws + WS_ACT;
    bf16 *WOUT = (bf16*)(ws + WS_WOUT), *WIN_ = (bf16*)(ws + WS_WIN), *XN = (bf16*)(ws + WS_XN), *PN = (bf16*)(ws + WS_PN), *PT = (bf16*)(ws + WS_PT),
         *MG = (bf16*)(ws + WS_MERGED), *YB = (bf16*)(ws + WS_YB);
    bf16* H = (bf16*)(ws + WS_H);
    int* tk_e = (int*)(ws + WS_TK); int* tk_slot = tk_e + T * 4; float* tk_gate = (float*)(tk_slot + T * 4); int* tk_dest = (int*)(tk_gate + T * 4);
    const int lo = args.ph_lo, hi = args.ph_hi;
#define IN(k) (lo <= (k) && (k) < hi)
    volatile LAS unsigned* MISC = (volatile LAS unsigned*)(L + LDSCTL_OFF);
    if (tid < 16) MISC[tid] = 0u;
    __syncthreads();
    XcdBarrier bar; bar.bar = ctl + CW_BAR + args.li * XCD_BAR_WORDS; bar.x = 0; bar.st = nullptr;
    if (hi - lo > 1) bar = xcd_barrier_post(ctl + CW_BAR + args.li * XCD_BAR_WORDS, MISC + 8);
#define BAR(k) do { if (IN(k) && IN((k) + 1)) xcd_barrier(bar); } while (0)

    if (IN(0)) {
        LAS float* scr = (LAS float*)(L + wave * 16384);
        constexpr int I_IN = 16 * (INW / 32), I_OUT = 16 * 32, NITEMS = I_IN + I_OUT;
        for (int it = gw; it < NITEMS; it += NGW) {
            int r = it;
            if (r < I_IN) { const int kb = r / (INW / 32), nb = r % (INW / 32), orow = nb * 32; const bool f8 = (orow >= NAT16 && orow < NATW + TR8);
                if (f8) transpose_item8(w_in, INW, D, kb * 64, win_row_to_col(orow), ws + WS_WIN8, orow, scr, lane); else transpose_item(w_in, INW, D, kb * 64, win_row_to_col(orow), WIN_, orow, scr, lane); continue; } r -= I_IN;
            { const int kb = r / 32, nb = r % 32; transpose_item(w_out, D, D, kb * 64, nb * 32, WOUT, nb * 32, scr, lane); }
        }
        for (int m = gw; m < T; m += NGW) {
            const f32x4* xr = (const f32x4*)(x + (size_t)m * D) + lane; const f32x4* gr = (const f32x4*)g_mix + lane;
            f32x4 v[4]; float s = 0.f;
#pragma unroll
            for (int j = 0; j < 4; ++j) { v[j] = xr[64 * j]; s += (v[j].x * v[j].x + v[j].y * v[j].y) + (v[j].z * v[j].z + v[j].w * v[j].w); }
            const float rstd = rsqrtf(wave_sum(s) * (1.0f / D) + EPS);
            unsigned long long* o8 = (unsigned long long*)(XN + (size_t)m * D) + lane;
            unsigned* o4 = (unsigned*)(ws + WS_XN8 + (size_t)m * D) + lane;
#pragma unroll
            for (int j = 0; j < 4; ++j) { const f32x4 g = gr[64 * j]; const float a0 = v[j].x * rstd * g.x, a1 = v[j].y * rstd * g.y, a2 = v[j].z * rstd * g.z, a3 = v[j].w * rstd * g.w;
                o8[64 * j] = (unsigned long long)pk2(a0, a1) | ((unsigned long long)pk2(a2, a3) << 32);
                int w = 0; w = __builtin_amdgcn_cvt_pk_fp8_f32(a0, a1, w, false); w = __builtin_amdgcn_cvt_pk_fp8_f32(a2, a3, w, true); o4[64 * j] = (unsigned)w; }
        }
    }
    BAR(0);
    if (IN(1)) {
        const bf16* XN8 = (const bf16*)(ws + WS_XN8); const unsigned char* WIN8 = ws + WS_WIN8;
        { pg8::Gemm g{XN, WIN_, T, NAT16, D}; pg8::StaticOrder S; S.init(T, NAT16, G, bx); pg8::EpiNatMk<false> E{PN, 0};
          pg8::gemm_phase<pg8::EpiNatMk<false>, pg8::StaticOrder, true, true>(L, g, S, E); }
        { pg8::Gemm g{WIN_ + (size_t)(NATW + TR8) * D, XN, TRW - TR8, T, D}; pg8::StaticOrder S; S.init(TRW - TR8, T, G, G - 1 - bx); pg8::EpiTrMk<false> E{PT, lbf, lbb, TR8 / 256};
          pg8::gemm_phase<pg8::EpiTrMk<false>, pg8::StaticOrder, true, true>(L, g, S, E); }
        { pg8::Gemm g{XN8, (const bf16*)(WIN8 + (size_t)NAT16 * D), T, NATW - NAT16, D / 2}; pg8::StaticOrder S; S.init(T, NATW - NAT16, G, bx); pg8::EpiNatMk<true> E{PN, NAT16 / 256};
          pg8::gemm_phase<pg8::EpiNatMk<true>, pg8::StaticOrder, true, true, true>(L, g, S, E); }
        { pg8::Gemm g{(const bf16*)(WIN8 + (size_t)NATW * D), XN8, TR8, T, D / 2}; pg8::StaticOrder S; S.init(TR8, T, G, bx); pg8::EpiTrMk<true> E{PT, lbf, lbb, 0};
          pg8::gemm_phase<pg8::EpiTrMk<true>, pg8::StaticOrder, true, true, true>(L, g, S, E); }
    }
    BAR(1);
    if (IN(2)) {
        const float* sink = args.in[6]; bf16* YA = (bf16*)(ws + WS_YA);
        constexpr int NU = NB * AKH * (SEQ / 16);
        LAS float* scr = (LAS float*)(L + wave * 16384);
        constexpr int I_UG = NE * 16 * 64, I_D = NE * 16 * 32, NCONV = I_UG + I_D;
        int cit = gw;
#define CONV_ITEMS(n_) do { for (int q_ = 0; q_ < (n_) && cit < NCONV; q_ += 4) { \
            if (cit + 3 * NGW < NCONV) { conv_batch4(cit, NGW, w_ug, w_d, WUG, WD, scr, lane); cit += 4 * NGW; } \
            else { const float* s0_; unsigned char* d0_; int n0_; float t0_[32]; moe_item_desc(cit, w_ug, w_d, WUG, WD, s0_, n0_, d0_); conv_issue(s0_, n0_, lane, t0_); conv_finish(t0_, d0_, D, scr, lane); cit += NGW; } } } while (0)
        if (wave >= 4) CONV_ITEMS(8);
        for (int u = gw; u < 2 * NU; u += NGW) { const int qt = u % (SEQ / 16), hh = (u / (SEQ / 16)) & 1, kv = (u / (SEQ / 8)) % AKH, b = u / (SEQ / 8 * AKH); attn_unit(PN, PT, sink, YA, b, kv, qt, hh, lane); CONV_ITEMS(4); }
        { const int dir = wave & 1; const HgConst K = hg_make_const(lane, dir); unsigned char* U = ws + WS_U; float* DEC = (float*)(ws + WS_DEC);
          for (int i = gw >> 1; i < 2048; i += NGW / 2) { hg_pass1(PT, U, DEC, i * 2 + dir, lane, K, dir); CONV_ITEMS(4); } }
        CONV_ITEMS(1 << 30);
#undef CONV_ITEMS
    }
    BAR(2);
    if (IN(3)) {
        const unsigned char* U = ws + WS_U; unsigned char* Sst = ws + WS_OF; const float* DEC = (const float*)(ws + WS_DEC);
        for (int i = vcu * NTHREADS + tid; i < 32 * 4096; i += G * NTHREADS) {
            const int el4 = i & 4095, chain = i >> 12, dir = chain & 1, bh = chain >> 1, d4 = 32 * ((el4 >> 7) & 3) + 16 * (el4 & 1) + 4 * ((el4 >> 5) & 3);
            f32x4 st = Z4;
            const unsigned char* ub = U + (size_t)bh * 128 * 2 * 16384 + (size_t)dir * 16384 + el4 * 4; unsigned char* sb_ = Sst + (size_t)bh * 128 * 2 * 16384 + (size_t)dir * 16384 + el4 * 4; const float* db = DEC + (size_t)bh * 128 * 2 * 128 + dir * 128 + d4;
#pragma unroll 1
            for (int k0 = 0; k0 < NCH; k0 += 32) {
                unsigned u[32]; f32x4 dc[32];
#pragma unroll
                for (int j = 0; j < 32; ++j) { const int n = dir ? NCH - 1 - (k0 + j) : (k0 + j); u[j] = *(const unsigned*)(ub + (size_t)n * 2 * 16384); dc[j] = *(const f32x4*)(db + (size_t)n * 2 * 128); }
#pragma unroll
                for (int j = 0; j < 32; ++j) { const int n = dir ? NCH - 1 - (k0 + j) : (k0 + j);
                    *(unsigned*)(sb_ + (size_t)n * 2 * 16384) = pk4_fp8(st[0], st[1], st[2], st[3]);
                    const f32x2_t lo = __builtin_amdgcn_cvt_pk_f32_fp8((int)u[j], false), hi = __builtin_amdgcn_cvt_pk_f32_fp8((int)u[j], true);
                    st[0] = dc[j][0] * st[0] + lo[0]; st[1] = dc[j][1] * st[1] + lo[1]; st[2] = dc[j][2] * st[2] + hi[0]; st[3] = dc[j][3] * st[3] + hi[1]; }
            }
        }
    }
    BAR(3);
    if (IN(4)) {
        const unsigned char* U = ws + WS_OF; const bf16* YA = (const bf16*)(ws + WS_YA); const float* gng = args.in[5];
        const int dir = wave & 1, pr = wave >> 1; const HgConst K = hg_make_const(lane, dir);
        LAS unsigned char* myslot = L + pr * 32768 + dir * 16384; LAS unsigned char* oslot = L + pr * 32768 + (dir ^ 1) * 16384;
        LAS float* myss = (LAS float*)(L + SS_OFF + wave * 1024); LAS float* oss = (LAS float*)(L + SS_OFF + (wave ^ 1) * 1024);
        for (int wi = vcu; wi < 512; wi += G) { const int bhn = wi * 4 + pr;
            f32x4 keep[4][4];
            if (dir) hg_pass3_a<1>(PN, PT, U, bhn, lane, K, keep, myslot); else hg_pass3_a<0>(PN, PT, U, bhn, lane, K, keep, myslot);
            __syncthreads();
            hg_pass3_b(lane, keep, oslot, myss);
            __syncthreads();
            hg_pass3_c(PN, YA, gng, MG, bhn, lane, dir, keep, myss, oss);
            __syncthreads();
        }
    }
    BAR(4);
    if (IN(5)) {
        pg8::Gemm g{MG, WOUT, T, D, D}; pg8::StaticOrder S; S.init(T, D, G, bx); pg8::EpiResidMk E{x, H};
        pg8::gemm_phase<pg8::EpiResidMk, pg8::StaticOrder, true, true>(L, g, S, E);
    }
    BAR(5);
    if (IN(6)) {
        const float* g_ffn = args.in[8]; const float* w_r = args.in[9]; const float* b_r = args.in[10];
        unsigned char* XN2 = ws + WS_XN2; int* elist = (int*)(ws + WS_XG);
        LAS float* WrT = (LAS float*)L; constexpr int WP = 1028;
        { f32x4 wq[16]; float gk[16];
#pragma unroll
          for (int q = 0; q < 16; ++q) { const int i4 = tid + q * NTHREADS; wq[q] = ((const f32x4*)w_r)[i4]; gk[q] = g_ffn[i4 >> 3]; }
#pragma unroll
          for (int q = 0; q < 16; ++q) { const int i4 = tid + q * NTHREADS, k = i4 >> 3, e = (i4 & 7) * 4;
#pragma unroll
              for (int t = 0; t < 4; ++t) WrT[(e + t) * WP + k] = wq[q][t] * gk[q]; } }
        volatile LAS int* lcnt = (volatile LAS int*)(L + META_OFF);
        LAS int* asg = (LAS int*)(L + SS_OFF);
        LAS float* lg = (LAS float*)(L + SS_OFF + 1024);
        const int c = lane & 15, g = lane >> 4, mt = wave >> 1, nt = wave & 1;
        for (int blk = vcu; blk < T / 64; blk += G) {
            if (tid < 32) lcnt[tid] = 0;
            __syncthreads();
            v4u hq[8][2];
#pragma unroll
            for (int rr = 0; rr < 8; ++rr) { const v4u* hr = (const v4u*)(H + (size_t)(blk * 64 + wave * 8 + rr) * D) + lane; hq[rr][0] = hr[0]; hq[rr][1] = hr[64]; }
#pragma unroll
            for (int rr = 0; rr < 8; ++rr) { const int row = blk * 64 + wave * 8 + rr;
                const f32x4* gr = (const f32x4*)g_ffn + 2 * lane;
                f32x4 v[4]; float ssq = 0.f;
#pragma unroll
                for (int j = 0; j < 2; ++j) { const v4u q = hq[rr][j];
                    v[2 * j] = (f32x4){__uint_as_float(q.x << 16), __uint_as_float(q.x & 0xffff0000u), __uint_as_float(q.y << 16), __uint_as_float(q.y & 0xffff0000u)};
                    v[2 * j + 1] = (f32x4){__uint_as_float(q.z << 16), __uint_as_float(q.z & 0xffff0000u), __uint_as_float(q.w << 16), __uint_as_float(q.w & 0xffff0000u)}; }
#pragma unroll
                for (int j = 0; j < 4; ++j) ssq += (v[j].x * v[j].x + v[j].y * v[j].y) + (v[j].z * v[j].z + v[j].w * v[j].w);
                const float rstd = rsqrtf(wave_sum(ssq) * (1.0f / D) + EPS);
                uint2* o8 = (uint2*)(XN2 + (size_t)row * D) + lane;
#pragma unroll
                for (int j = 0; j < 2; ++j) { int w[2];
#pragma unroll
                    for (int hh = 0; hh < 2; ++hh) { const f32x4 t = v[2 * j + hh] * rstd * gr[128 * j + hh]; int ww = 0; ww = __builtin_amdgcn_cvt_pk_fp8_f32(t.x, t.y, ww, false); ww = __builtin_amdgcn_cvt_pk_fp8_f32(t.z, t.w, ww, true); w[hh] = ww; }
                    o8[64 * j] = make_uint2((unsigned)w[0], (unsigned)w[1]); } }
            { const bf16* hb = H + (size_t)(blk * 64 + 16 * mt + c) * D + 8 * g; const LAS float* wb = WrT + (16 * nt + c) * WP + 8 * g;
              f32x4 acc = Z4; float ssq = 0.f;
#pragma unroll 8
              for (int q = 0; q < 32; ++q) { const v4u aq = *(const v4u*)(hb + 32 * q); const f32x4 b0 = *(const LAS f32x4*)(wb + 32 * q), b1 = *(const LAS f32x4*)(wb + 32 * q + 4);
                  const f32x4 a0 = {__uint_as_float(aq.x << 16), __uint_as_float(aq.x & 0xffff0000u), __uint_as_float(aq.y << 16), __uint_as_float(aq.y & 0xffff0000u)};
                  const f32x4 a1 = {__uint_as_float(aq.z << 16), __uint_as_float(aq.z & 0xffff0000u), __uint_as_float(aq.w << 16), __uint_as_float(aq.w & 0xffff0000u)};
                  ssq += ((a0.x * a0.x + a0.y * a0.y) + (a0.z * a0.z + a0.w * a0.w)) + ((a1.x * a1.x + a1.y * a1.y) + (a1.z * a1.z + a1.w * a1.w));
                  acc = __builtin_amdgcn_mfma_f32_16x16x4f32(a0.x, b0.x, acc, 0, 0, 0); acc = __builtin_amdgcn_mfma_f32_16x16x4f32(a0.y, b0.y, acc, 0, 0, 0);
                  acc = __builtin_amdgcn_mfma_f32_16x16x4f32(a0.z, b0.z, acc, 0, 0, 0); acc = __builtin_amdgcn_mfma_f32_16x16x4f32(a0.w, b0.w, acc, 0, 0, 0);
                  acc = __builtin_amdgcn_mfma_f32_16x16x4f32(a1.x, b1.x, acc, 0, 0, 0); acc = __builtin_amdgcn_mfma_f32_16x16x4f32(a1.y, b1.y, acc, 0, 0, 0);
                  acc = __builtin_amdgcn_mfma_f32_16x16x4f32(a1.z, b1.z, acc, 0, 0, 0); acc = __builtin_amdgcn_mfma_f32_16x16x4f32(a1.w, b1.w, acc, 0, 0, 0); }
              ssq += __shfl_xor(ssq, 16); ssq += __shfl_xor(ssq, 32);
              const float rstd = rsqrtf(ssq * (1.0f / D) + EPS); const float bias = b_r[16 * nt + c];
#pragma unroll
              for (int r = 0; r < 4; ++r) { const float rs = __shfl(rstd, 4 * g + r); lg[(16 * mt + 4 * g + r) * 33 + 16 * nt + c] = acc[r] * rs + bias; } }
            __syncthreads();
            if (tid < 64) { const int row = blk * 64 + tid; float lv[32];
#pragma unroll
                for (int e = 0; e < 32; ++e) lv[e] = lg[tid * 33 + e];
                float tv[4]; int te[4];
#pragma unroll
                for (int k = 0; k < 4; ++k) { float m = -INFINITY; int mi = 0;
#pragma unroll
                    for (int e = 0; e < 32; ++e) { const bool used = (k > 0 && te[0] == e) || (k > 1 && te[1] == e) || (k > 2 && te[2] == e); if (!used && lv[e] > m) { m = lv[e]; mi = e; } }
                    tv[k] = m; te[k] = mi; }
                const float e1 = __expf(tv[1] - tv[0]), e2 = __expf(tv[2] - tv[0]), e3 = __expf(tv[3] - tv[0]); const float inv = 1.0f / (1.0f + e1 + e2 + e3);
                const float gts[4] = {inv, e1 * inv, e2 * inv, e3 * inv};
#pragma unroll
                for (int k = 0; k < 4; ++k) { tk_e[row * 4 + k] = te[k]; tk_gate[row * 4 + k] = gts[k];
                    const int ls = __hip_atomic_fetch_add((LAS int*)(L + META_OFF) + te[k], 1, __ATOMIC_RELAXED, __HIP_MEMORY_SCOPE_WORKGROUP); asg[tid * 4 + k] = (te[k] << 16) | ls; } }
            __syncthreads();
            if (tid < 32) lcnt[32 + tid] = (int)atomicAdd(&ctl[CW_CNT + tid * CNT_STRIDE], (unsigned)lcnt[tid]);
            __syncthreads();
            if (tid < 256) { const int pk = asg[tid], e_ = pk >> 16, gs = lcnt[32 + e_] + (pk & 0xffff); tk_slot[blk * 256 + tid] = gs; elist[(size_t)e_ * 16384 + gs] = blk * 64 + (tid >> 2); }
            __syncthreads();
        }
    }
    if (IN(6) && IN(8)) xcd_barrier(bar);
#define MOE_META(NCT_) do { __syncthreads(); \
        if (tid == 0) { int uo = 0, tb = 0; for (int e = 0; e < NE; ++e) { const int nt = (int)((__hip_atomic_load(ctl + CW_CNT + e * CNT_STRIDE, __ATOMIC_RELAXED, __HIP_MEMORY_SCOPE_AGENT) + 255u) >> 8); \
            meta[e] = uo; meta[40 + e] = tb; meta[80 + e] = nt > 0 ? nt : 1; meta[120 + e] = (int)__hip_atomic_load(ctl + CW_CNT + e * CNT_STRIDE, __ATOMIC_RELAXED, __HIP_MEMORY_SCOPE_AGENT); uo += nt * (NCT_); tb += nt; } meta[32] = uo; } \
        __syncthreads(); } while (0)
    if (IN(8)) {
        volatile LAS int* meta = (volatile LAS int*)(L + META_OFF);
        MOE_META(8);
        pg8::MoeOrder<true> S{meta, 8, G, bx, (const int*)(ws + WS_XG)}; pg8::Gemm g{(const bf16*)(ws + WS_XN2), (const bf16*)WUG, NPAD, NE * 2048, D / 2}; pg8::EpiSwigluMk E{ACT, b_ug};
        pg8::gemm_phase<pg8::EpiSwigluMk, pg8::MoeOrder<true>, true, true, true>(L, g, S, E);
    }
    BAR(8);
    if (IN(9)) {
        volatile LAS int* meta = (volatile LAS int*)(L + META_OFF);
        MOE_META(4);
        pg8::MoeOrder<false> S{meta, 4, G, bx, nullptr}; pg8::Gemm g{(const bf16*)ACT, (const bf16*)WD, NPAD, NE * D, D / 2}; pg8::EpiDownMk E{YB, b_d};
        pg8::gemm_phase<pg8::EpiDownMk, pg8::MoeOrder<false>, true, true, true>(L, g, S, E);
    }
#undef MOE_META
    BAR(9);
    if (IN(10)) {
        const float* g_fin = args.in[15];
        volatile LAS int* meta = (volatile LAS int*)(L + META_OFF);
        __syncthreads();
        if (tid == 0) { int bs = 0; for (int e = 0; e < NE; ++e) { meta[e] = bs; bs += (int)((__hip_atomic_load(ctl + CW_CNT + e * CNT_STRIDE, __ATOMIC_RELAXED, __HIP_MEMORY_SCOPE_AGENT) + 255u) & ~255u); } }
        __syncthreads();
        const f32x4* gr = (const f32x4*)g_fin + lane; f32x4 gq[4];
#pragma unroll
        for (int j = 0; j < 4; ++j) gq[j] = gr[64 * j];
        for (int base = gw * 8; base < T; base += NGW * 8) {
            int my_dest = 0; float my_gate = 0.f;
            if (lane < 32) { const int a_ = base * 4 + lane; my_dest = meta[tk_e[a_]] + tk_slot[a_]; my_gate = tk_gate[a_]; }
            uint2 hA[4], hB[4], hC[4], hD[4]; uint2 yA[4][4], yB[4][4], yC[4][4], yD[4][4]; float gA[4], gB[4], gC[4], gD[4];
#define P10_LOAD(r_, h_, y_, g_) do { _Pragma("unroll") for (int k = 0; k < 4; ++k) { const int d_ = __shfl(my_dest, (r_) * 4 + k); g_[k] = __shfl(my_gate, (r_) * 4 + k); const uint2* yp = (const uint2*)(YB + (size_t)d_ * D) + lane; \
                _Pragma("unroll") for (int j = 0; j < 4; ++j) y_[k][j] = yp[64 * j]; } \
            { const uint2* hr = (const uint2*)(H + (size_t)(base + (r_)) * D) + lane; _Pragma("unroll") for (int j = 0; j < 4; ++j) h_[j] = hr[64 * j]; } } while (0)
#define P10_DO(r_, h_, y_, g_) do { f32x4 v[4]; _Pragma("unroll") for (int j = 0; j < 4; ++j) v[j] = (f32x4){__uint_as_float(h_[j].x << 16), __uint_as_float(h_[j].x & 0xffff0000u), __uint_as_float(h_[j].y << 16), __uint_as_float(h_[j].y & 0xffff0000u)}; \
            _Pragma("unroll") for (int k = 0; k < 4; ++k) _Pragma("unroll") for (int j = 0; j < 4; ++j) { const uint2 w = y_[k][j]; const float gt = g_[k]; \
                v[j].x += gt * __uint_as_float(w.x << 16); v[j].y += gt * __uint_as_float(w.x & 0xffff0000u); v[j].z += gt * __uint_as_float(w.y << 16); v[j].w += gt * __uint_as_float(w.y & 0xffff0000u); } \
            float ssq = 0.f; _Pragma("unroll") for (int j = 0; j < 4; ++j) ssq += (v[j].x * v[j].x + v[j].y * v[j].y) + (v[j].z * v[j].z + v[j].w * v[j].w); \
            const float rstd = rsqrtf(wave_sum(ssq) * (1.0f / D) + EPS); f32x4* orow = (f32x4*)(args.out + (size_t)(base + (r_)) * D) + lane; \
            _Pragma("unroll") for (int j = 0; j < 4; ++j) orow[64 * j] = v[j] * rstd * gq[j]; } while (0)
            P10_LOAD(0, hA, yA, gA); P10_LOAD(1, hB, yB, gB); P10_LOAD(2, hC, yC, gC); P10_LOAD(3, hD, yD, gD);
            P10_DO(0, hA, yA, gA); P10_LOAD(4, hA, yA, gA); P10_DO(1, hB, yB, gB); P10_LOAD(5, hB, yB, gB); P10_DO(2, hC, yC, gC); P10_LOAD(6, hC, yC, gC); P10_DO(3, hD, yD, gD); P10_LOAD(7, hD, yD, gD);
            P10_DO(4, hA, yA, gA); P10_DO(5, hB, yB, gB); P10_DO(6, hC, yC, gC); P10_DO(7, hD, yD, gD);
#undef P10_LOAD
#undef P10_DO
        }
    }
#undef IN
#undef BAR
}

extern "C" void kernel_launch(void* const* d_in, const int* in_sizes, int n_in, void* d_out, int out_size, void* d_ws, size_t ws_size, hipStream_t stream) {
    if (n_in != 16 || in_sizes[0] != T * D || out_size != T * D || ws_size < WS_END) { fprintf(stderr, "kernel_launch: unexpected shapes / workspace (%zu < %zu)\n", ws_size, (size_t)WS_END); return; }
    char* ws = (char*)d_ws; float* out = (float*)d_out;
    (void)hipMemsetAsync(ws + WS_CTL, 0, 65536, stream);
    static int grid = 0;
    if (grid == 0) { int dev = 0, cus = 0, per_cu = 0; hipGetDevice(&dev); hipDeviceGetAttribute(&cus, hipDeviceAttributeMultiprocessorCount, dev);
        hipFuncSetAttribute((const void*)mk_fwd, hipFuncAttributeMaxDynamicSharedMemorySize, LDS_BYTES);
        hipOccupancyMaxActiveBlocksPerMultiprocessor(&per_cu, (const void*)mk_fwd, NTHREADS, LDS_BYTES);
        if (per_cu < 1) { fprintf(stderr, "kernel_launch: occupancy query says %d blocks/CU\n", per_cu); per_cu = 1; }
        (void)hipGetLastError(); grid = cus; }
    Args a{}; for (int i = 0; i < 16; ++i) a.in[i] = (const float*)d_in[i]; a.out = out; a.ws = (unsigned char*)d_ws;
#define MK(lo_, hi_) do { a.ph_lo = lo_; a.ph_hi = hi_; hipLaunchKernelGGL(mk_fwd, dim3(grid), dim3(NTHREADS), LDS_BYTES, stream, a); a.li++; } while (0)
    if (PROBE_LO < 0) { MK(0, 11); } else { MK(0, PROBE_HI); MK(PROBE_LO, PROBE_HI); if (PROBE_HI < 11) MK(PROBE_HI, 11); }
}
```

```cpp
#include <hip/hip_runtime.h>
#include <cstdio>
#include <cstdint>

typedef unsigned short bf16;
#define DI __device__ __forceinline__

constexpr int NB = 2, SEQ = 8192, T = NB * SEQ, D = 1024;
constexpr int HGH = 8, DK = 128, DV = 128, CH = 64, NCH = SEQ / CH;
constexpr int AQH = 16, AKH = 4, AHD = 64, WIN = 128;
constexpr int NE = 32, TOPK = 4, FF = 1024;
constexpr float EPS = 1e-5f, SW_LIM = 7.0f, SW_ALPHA = 1.702f;
constexpr int INW = 8704;
constexpr int C_HQ = 0, C_FF = 1024, C_FB = 2048, C_HI = 3072, C_HG = 4096, C_AQ = 5120, C_AK = 6144, C_AV = 6400, C_GA = 6656, C_GB = 7680;
constexpr int NATW = 5376, N_Q = 0, N_G = 1024, N_AQ = 2048, N_AK = 3072, N_GA = 3328, N_GB = 4352;
constexpr int TRW = 3328, R_GF = 0, R_GB = 1024, R_V = 2048, R_AV = 3072;
constexpr int NPAD = T * TOPK + NE * 256;
constexpr float QSCALE = 0.125f * 1.4426950408889634f;
constexpr int NAT16 = 2048, TR8 = 2048;
constexpr float W8_SCALE = 32.0f, W8_INV = 1.0f / 32.0f;

constexpr size_t MiB = 1u << 20;
constexpr size_t WS_CTL = 0;
constexpr size_t WS_WUG = 1 * MiB;
constexpr size_t WS_WD = WS_WUG + 128 * MiB;
constexpr size_t WS_WOUT = WS_WD + 64 * MiB;
constexpr size_t WS_H = WS_WOUT + 2 * MiB;
constexpr size_t WS_MERGED = WS_H + 64 * MiB;
constexpr size_t WS_TK = WS_MERGED + 32 * MiB;
constexpr size_t WS_B = WS_TK + 1 * MiB;
constexpr size_t WS_WIN = WS_B;
constexpr size_t WS_XN = WS_WIN + 17 * MiB;
constexpr size_t WS_PN = WS_XN + 32 * MiB;
constexpr size_t WS_PT = WS_PN + 168 * MiB;
constexpr size_t WS_YA = WS_PT + 104 * MiB;
constexpr size_t WS_U = WS_YA + 32 * MiB;
constexpr size_t WS_DEC = WS_U + 128 * MiB;
constexpr size_t WS_OF = WS_DEC + 2 * MiB;
constexpr size_t WS_WIN8 = WS_OF, WS_XN8 = WS_OF + 16 * MiB;
constexpr size_t WS_B_END = WS_OF + 128 * MiB;
constexpr size_t WS_XN2 = WS_B;
constexpr size_t WS_XG = WS_XN2 + 32 * MiB;
constexpr size_t WS_ACT = WS_XG + 144 * MiB;
constexpr size_t WS_YB = WS_ACT + 144 * MiB;
constexpr size_t WS_END = (WS_B_END > WS_YB + 144 * MiB) ? WS_B_END : (WS_YB + 144 * MiB);
static_assert(true, "");
constexpr int CW_CNT = 1024, CNT_STRIDE = 64;
constexpr int CW_BAR = 4096;

DI float bf2f(bf16 b) { return __uint_as_float((unsigned)b << 16); }
DI bf16 f2bf(float f) { unsigned u = __float_as_uint(f); return (bf16)((u + 0x7fffu + ((u >> 16) & 1u)) >> 16); }
DI float sigmoidf_(float x) { return 1.0f / (1.0f + __expf(-x)); }
DI float wave_sum(float v) {
#pragma unroll
    for (int o = 1; o < 64; o <<= 1) v += __shfl_xor(v, o);
    return v;
}

DI int win_row_to_col(int r) {
    if (r < NATW) {
        if (r < N_G) return C_HQ + r;
        if (r < N_AQ) return C_HG + (r - N_G);
        if (r < N_AK) return C_AQ + (r - N_AQ);
        if (r < N_GA) return C_AK + (r - N_AK);
        if (r < N_GB) return C_GA + (r - N_GA);
        return C_GB + (r - N_GB);
    }
    r -= NATW;
    if (r < R_GB) return C_FF + r;
    if (r < R_V) return C_FB + (r - R_GB);
    if (r < R_AV) return C_HI + (r - R_V);
    return C_AV + (r - R_AV);
}
DI int wug_row_to_col(int p) { const int tile = p >> 8, c = p & 255; return c < 128 ? (tile * 128 + c) : (1024 + tile * 128 + (c - 128)); }

namespace pg8 {
#define PG8_LAS __attribute__((address_space(3)))
typedef unsigned short bf16_t;
typedef short bf16x8 __attribute__((ext_vector_type(8)));
typedef float f32x4 __attribute__((ext_vector_type(4)));
typedef unsigned u32x4 __attribute__((ext_vector_type(4)));
constexpr int BM = 256, BK = 64, HALF = 128, HTB = HALF * BK * 2  , STAGE_BYTES = 8 * HTB, NXCD = 8, WGM = 8;

__host__ __device__ __forceinline__ int lds_byte(int r, int c) { const int st = (r >> 4) * 2 + (c >> 5), rr = r & 15, cc = c & 31, ob = rr * 64 + cc * 2; return st * 1024 + (ob ^ (((ob >> 9) & 1) << 5)); }
__host__ __device__ __forceinline__ void stage_rc(int b, int& R, int& C) { const int st = b / 1024, sb = b % 1024, swz = sb ^ (((sb >> 9) & 1) << 5); R = (st >> 1) * 16 + swz / 64; C = (st & 1) * 32 + (swz % 64) / 2; }
__host__ __device__ __forceinline__ int perm32(int rho) { const int n = rho >> 4, i = rho & 15; return 8 * (i >> 2) + 4 * n + (i & 3); }

struct Unit { int pm, pn; int e, r0, cnt; };
struct Gemm { const bf16_t* A; const bf16_t* Bt; int M, N, K; };

struct StaticOrder {
    static constexpr bool GATHER = false;
    int nM, nN, nwg, G, c;
    __host__ __device__ void init(int M, int N, int G_, int c_) { nM = M / BM; nN = N / BM; nwg = nM * nN; G = G_; c = c_; }
    __host__ __device__ bool next(int i, Unit& u) const {
        const long L = (long)i * G + c; if (L >= nwg) return false;
        int wgid = (int)L; { const int q = nwg / NXCD, r = nwg % NXCD, xcd = wgid % NXCD, off = wgid / NXCD; wgid = (xcd < r ? xcd * (q + 1) : r * (q + 1) + (xcd - r) * q) + off; }
        const int nig = WGM * nN, gid = wgid / nig, fm = gid * WGM, gsz = (nM - fm) < WGM ? (nM - fm) : WGM;
        u.pm = fm + ((wgid % nig) % gsz); u.pn = (wgid % nig) / gsz; return true;
    }
    __device__ __forceinline__ void a_ready(const Unit&) const {}
    __device__ __forceinline__ void done(const Unit&) const {}
};
__device__ __forceinline__ unsigned cvt_pk_bf16(float lo, float hi) {
    typedef float f2_ __attribute__((ext_vector_type(2))); typedef __bf16 b2_ __attribute__((ext_vector_type(2))); const f2_ v = {lo, hi}; return __builtin_bit_cast(unsigned, __builtin_convertvector(v, b2_)); }
template <class Epi, class Sched, bool ALIGN_EPI = false, bool SP2 = false, bool FP8 = false>
__device__ __forceinline__ void gemm_phase(PG8_LAS unsigned char* lds, const Gemm g, const Sched& S, const Epi& E) {
    const int tid = threadIdx.x, wid = __builtin_amdgcn_readfirstlane(tid >> 6), lane = tid & 63, wr = wid >> 2, wc = wid & 3, fr = lane & 15, fq = lane >> 4;
    const int K = g.K, nt = K / BK;
    unsigned voffA[2], voffB[2];
    unsigned gv[2][2], gvn[2][2];
#pragma unroll
    for (int i = 0; i < 2; ++i) { int R, C; stage_rc(tid * 16 + i * 8192, R, C); const int Rb = Epi::PERM ? ((R & ~31) + perm32(R & 31)) : R;
        voffA[i] = (unsigned)(R * K + C) * 2u; voffB[i] = (unsigned)(Rb * K + C) * 2u; }
    const size_t kstep = (size_t)(BK * 2);
    const size_t hstep = (size_t)HALF * K * 2;
    const size_t tstep = 2 * hstep;
    const unsigned ldsw = (unsigned)wid * 1024u;
    const int aoff = lds_byte(wr * 64 + fr, fq * 8), boff = lds_byte(wc * 32 + fr, fq * 8);
#define PG8_SA(b, h) (((b) * 2 + (h)) * HTB)
#define PG8_SB(b, h) ((4 + (b) * 2 + (h)) * HTB)
#define PG8_STAGE(bufoff, gbase, voff) do { _Pragma("unroll") for (int _i = 0; _i < 2; ++_i) \
        __builtin_amdgcn_global_load_lds((const unsigned*)((const char*)(gbase) + (voff)[_i]), (PG8_LAS unsigned*)(lds + (bufoff) + ldsw + _i * 8192), 16, 0, 0); } while (0)
#define PG8_LDA(dst, b, h) do { if constexpr (FP8) { _Pragma("unroll") for (int m = 0; m < 4; ++m) { const v4i_ lo_ = *(const PG8_LAS v4i_*)(lds + PG8_SA(b, h) + aoff + m * 2048), hi_ = *(const PG8_LAS v4i_*)(lds + PG8_SA(b, h) + aoff + m * 2048 + 1024); dst##8[m] = __builtin_shufflevector(lo_, hi_, 0, 1, 2, 3, 4, 5, 6, 7); } } \
        else { _Pragma("unroll") for (int m = 0; m < 4; ++m) _Pragma("unroll") for (int k = 0; k < 2; ++k) dst[m][k] = *(const PG8_LAS bf16x8*)(lds + PG8_SA(b, h) + aoff + m * 2048 + k * 1024); } } while (0)
#define PG8_LDB(dst, b, h) do { if constexpr (FP8) { _Pragma("unroll") for (int n = 0; n < 2; ++n) { const v4i_ lo_ = *(const PG8_LAS v4i_*)(lds + PG8_SB(b, h) + boff + n * 2048), hi_ = *(const PG8_LAS v4i_*)(lds + PG8_SB(b, h) + boff + n * 2048 + 1024); dst##8[n] = __builtin_shufflevector(lo_, hi_, 0, 1, 2, 3, 4, 5, 6, 7); } } \
        else { _Pragma("unroll") for (int n = 0; n < 2; ++n) _Pragma("unroll") for (int k = 0; k < 2; ++k) dst[n][k] = *(const PG8_LAS bf16x8*)(lds + PG8_SB(b, h) + boff + n * 2048 + k * 1024); } } while (0)
#define PG8_MMA(ai, bj, At, Bt) do { __builtin_amdgcn_s_setprio(1); _Pragma("unroll") for (int m = 0; m < 4; ++m) _Pragma("unroll") for (int n = 0; n < 2; ++n) { \
        if constexpr (FP8) asm volatile("v_mfma_scale_f32_16x16x128_f8f6f4 %0, %1, %2, %0, %3, %3 op_sel_hi:[0,0,0]" : "+v"(acc[ai][bj][m][n]) : "v"(Bt##8[n]), "v"(At##8[m]), "v"(one_scale));   \
        else { _Pragma("unroll") for (int k = 0; k < 2; ++k) acc[ai][bj][m][n] = __builtin_amdgcn_mfma_f32_16x16x32_bf16(Bt[n][k], At[m][k], acc[ai][bj][m][n], 0, 0, 0); } } \
        __builtin_amdgcn_s_setprio(0); } while (0)
#define PG8_WAIT_V(n) asm volatile("s_waitcnt vmcnt(" #n ")" ::: "memory")
#define PG8_WAIT_L(n) asm volatile("s_waitcnt lgkmcnt(" #n ")" ::: "memory")
#define PG8_BAR __builtin_amdgcn_s_barrier()
#define PG8_SCHED __builtin_amdgcn_sched_barrier(0)
    Unit cur, nxt, nn; int ui = 0;
    if (!S.next(0, cur)) return;
    bool has_next = S.next(1, nxt);
    f32x4 acc[2][2][4][2];
#pragma unroll
    for (int a = 0; a < 2; ++a)
#pragma unroll
        for (int b = 0; b < 2; ++b)
#pragma unroll
            for (int m = 0; m < 4; ++m)
#pragma unroll
                for (int n = 0; n < 2; ++n) { acc[a][b][m][n] = (f32x4){0.f, 0.f, 0.f, 0.f}; }
    if constexpr (Epi::INIT_ACC) E.init_acc(acc, cur, wr, wc, fr, fq);
    typedef int v8i_ __attribute__((ext_vector_type(8))); typedef int v4i_ __attribute__((ext_vector_type(4)));
    int one_scale = 0x7f7f7f7f; asm volatile("" : "+v"(one_scale));
    bf16x8 At[4][2], B0[2][2], B1[2][2]; v8i_ At8[4], B08[2], B18[2];
    const char* cA = (const char*)g.A + (Sched::GATHER ? (size_t)0 : (size_t)cur.pm * tstep); const char* cB = (const char*)g.Bt + (size_t)cur.pn * tstep;
    if constexpr (Sched::GATHER) { S.gather_voffs(cur, K, tid, gv); if (has_next) S.gather_voffs(nxt, K, tid, gvn); }
#define PG8_STAGEA(bufoff, ptr, h, nx) do { if constexpr (Sched::GATHER) { const unsigned sel_[2] = {(nx) ? gvn[h][0] : gv[h][0], (nx) ? gvn[h][1] : gv[h][1]}; PG8_STAGE(bufoff, ptr, sel_); } \
        else { PG8_STAGE(bufoff, (ptr) + (h) * hstep, voffA); } } while (0)
    S.a_ready(cur);
    if constexpr (SP2) {
        PG8_STAGE(PG8_SB(0, 0), cB, voffB); PG8_STAGE(PG8_SB(0, 1), cB + hstep, voffB); PG8_STAGEA(PG8_SA(0, 0), cA, 0, false); PG8_STAGEA(PG8_SA(0, 1), cA, 1, false);
        if (wr == 1) PG8_BAR;
        PG8_WAIT_V(2); PG8_BAR;
        PG8_STAGE(PG8_SB(1, 0), cB + kstep, voffB); PG8_STAGEA(PG8_SA(1, 0), cA + kstep, 0, false); PG8_STAGE(PG8_SB(1, 1), cB + hstep + kstep, voffB);
        PG8_WAIT_V(6); PG8_BAR;
    } else {
        PG8_STAGE(PG8_SB(0, 0), cB, voffB); PG8_STAGE(PG8_SA(0, 0), cA, voffA); PG8_STAGE(PG8_SB(0, 1), cB + hstep, voffB); PG8_STAGE(PG8_SA(0, 1), cA + hstep, voffA);
        if (wr == 1) PG8_BAR;
        PG8_WAIT_V(4); PG8_BAR;
        PG8_STAGE(PG8_SB(1, 0), cB + kstep, voffB); PG8_STAGE(PG8_SA(1, 0), cA + kstep, voffA); PG8_STAGE(PG8_SB(1, 1), cB + hstep + kstep, voffB);
        PG8_WAIT_V(6); PG8_BAR;
    }
    for (;;) {
        const char* nA = has_next ? (const char*)g.A + (Sched::GATHER ? (size_t)0 : (size_t)nxt.pm * tstep) : cA; const char* nB = has_next ? (const char*)g.Bt + (size_t)nxt.pn * tstep : cB;
#pragma unroll 1
        for (int t = 0; t < nt; t += 2) {
            const bool last = (t == nt - 2); const bool nx = last && has_next;
            const char* a1 = cA + (size_t)(t + 1) * kstep;
            const char* a2 = last ? nA : cA + (size_t)(t + 2) * kstep; const char* b2 = last ? nB : cB + (size_t)(t + 2) * kstep;
            const char* a3 = a2 + kstep; const char* b3 = b2 + kstep;
            if (last && has_next) S.a_ready(nxt);
            if constexpr (SP2) {
            PG8_LDB(B0, 0, 0); PG8_LDB(B1, 0, 1); PG8_SCHED; PG8_LDA(At, 0, 0); PG8_STAGEA(PG8_SA(1, 1), a1, 1, false);
            PG8_WAIT_V(8); PG8_WAIT_L(0); PG8_BAR; PG8_MMA(0, 0, At, B0); PG8_MMA(0, 1, At, B1); PG8_BAR; PG8_SCHED;
            PG8_LDA(At, 0, 1); PG8_STAGE(PG8_SB(0, 0), b2, voffB); PG8_STAGE(PG8_SB(0, 1), b2 + hstep, voffB); PG8_STAGEA(PG8_SA(0, 0), a2, 0, nx);
            PG8_WAIT_V(8); PG8_WAIT_L(0); PG8_BAR; PG8_MMA(1, 0, At, B0); PG8_MMA(1, 1, At, B1); PG8_BAR; PG8_SCHED;
            PG8_LDB(B0, 1, 0); PG8_LDB(B1, 1, 1); PG8_SCHED; PG8_LDA(At, 1, 0); PG8_STAGEA(PG8_SA(0, 1), a2, 1, nx);
            PG8_WAIT_V(8); PG8_WAIT_L(0); PG8_BAR; PG8_MMA(0, 0, At, B0); PG8_MMA(0, 1, At, B1); PG8_BAR; PG8_SCHED;
            PG8_LDA(At, 1, 1); PG8_STAGE(PG8_SB(1, 0), b3, voffB); PG8_STAGE(PG8_SB(1, 1), b3 + hstep, voffB); PG8_STAGEA(PG8_SA(1, 0), a3, 0, nx);
            PG8_WAIT_V(8); PG8_WAIT_L(0); PG8_BAR; PG8_MMA(1, 0, At, B0); PG8_MMA(1, 1, At, B1); PG8_BAR; PG8_SCHED;
            } else {
            PG8_LDB(B0, 0, 0); PG8_SCHED; PG8_LDA(At, 0, 0); PG8_STAGE(PG8_SA(1, 1), a1 + hstep, voffA);
            PG8_WAIT_L(8); PG8_BAR; PG8_WAIT_L(0); PG8_MMA(0, 0, At, B0); PG8_BAR; PG8_SCHED;
            PG8_LDB(B1, 0, 1); PG8_STAGE(PG8_SB(0, 0), b2, voffB);
            PG8_BAR; PG8_WAIT_L(0); PG8_MMA(0, 1, At, B1); PG8_BAR;
            PG8_LDA(At, 0, 1); PG8_STAGE(PG8_SA(0, 0), a2, voffA);
            PG8_BAR; PG8_WAIT_L(0); PG8_MMA(1, 0, At, B0); PG8_BAR; PG8_SCHED;
            PG8_STAGE(PG8_SB(0, 1), b2 + hstep, voffB);
            PG8_WAIT_V(6); PG8_BAR; PG8_MMA(1, 1, At, B1); PG8_BAR;
            PG8_LDB(B0, 1, 0); PG8_SCHED; PG8_LDA(At, 1, 0); PG8_STAGE(PG8_SA(0, 1), a2 + hstep, voffA);
            PG8_WAIT_L(8); PG8_BAR; PG8_WAIT_L(0); PG8_MMA(0, 0, At, B0); PG8_BAR; PG8_SCHED;
            PG8_LDB(B1, 1, 1); PG8_STAGE(PG8_SB(1, 0), b3, voffB);
            PG8_BAR; PG8_WAIT_L(0); PG8_MMA(0, 1, At, B1); PG8_BAR;
            PG8_LDA(At, 1, 1); PG8_STAGE(PG8_SA(1, 0), a3, voffA);
            PG8_BAR; PG8_WAIT_L(0); PG8_MMA(1, 0, At, B0); PG8_BAR; PG8_SCHED;
            PG8_STAGE(PG8_SB(1, 1), b3 + hstep, voffB);
            PG8_WAIT_V(6); PG8_BAR; PG8_MMA(1, 1, At, B1); PG8_BAR;
            }
        }
        if constexpr (FP8) asm volatile("s_nop 15\n\ts_nop 15" ::: "memory");
        else asm volatile("s_nop 15" ::: "memory");
        if constexpr (ALIGN_EPI) { if (wr == 0) PG8_BAR; }
        bool has_nn = false; int gtok[2][2];
        if (has_next) { has_nn = S.next(ui + 2, nn); if constexpr (Sched::GATHER) { if (has_nn) S.gather_issue(nn, tid, gtok); } }
        if constexpr (!Epi::AFTER_DRAIN) { E(acc, cur, wr, wc, fr, fq); S.done(cur); }
        if (!has_next) break;
#pragma unroll
        for (int a = 0; a < 2; ++a)
#pragma unroll
            for (int b = 0; b < 2; ++b)
#pragma unroll
                for (int m = 0; m < 4; ++m)
#pragma unroll
                    for (int n = 0; n < 2; ++n) { acc[a][b][m][n] = (f32x4){0.f, 0.f, 0.f, 0.f}; }
        if constexpr (Epi::INIT_ACC) E.init_acc(acc, nxt, wr, wc, fr, fq);
        cur = nxt; cA = nA; cB = nB; ++ui;
        if constexpr (Sched::GATHER) { gv[0][0] = gvn[0][0]; gv[0][1] = gvn[0][1]; gv[1][0] = gvn[1][0]; gv[1][1] = gvn[1][1]; if (has_nn) S.gather_finish(gtok, K, tid, gvn); }
        nxt = nn; has_next = has_nn;
        if constexpr (ALIGN_EPI) { if (wr == 1) PG8_BAR; }
    }
    PG8_WAIT_V(0);
    if constexpr (!ALIGN_EPI) { if (wr == 0) PG8_BAR; }
    PG8_BAR;
    if constexpr (Epi::AFTER_DRAIN) { E.fused(acc, cur, wr, wc, fr, fq, lds, wid, lane); S.done(cur); }
#undef PG8_SA
#undef PG8_SB
#undef PG8_STAGE
#undef PG8_STAGEA
#undef PG8_LDA
#undef PG8_LDB
#undef PG8_MMA
#undef PG8_WAIT_V
#undef PG8_WAIT_L
#undef PG8_BAR
#undef PG8_SCHED
}
}

DI size_t ptb_blk(int f, int t) { return ((size_t)(f >> 4) * (T / 32) + (t >> 5)) * 512; }
DI size_t pn_stripe(size_t tok) { return (tok >> 4) * (size_t)(16 * NATW); }
DI size_t ya_stripe(size_t tok) { return (tok >> 4) * (size_t)(16 * D); }
namespace pg8 {
typedef float f32x2 __attribute__((ext_vector_type(2)));
DI float fsig(float x) { return __builtin_amdgcn_rcpf(1.0f + __expf(-x)); }
template <bool GATES> struct EpiNatMk {
    static constexpr bool PERM = true, AFTER_DRAIN = false, INIT_ACC = false;
    bf16_t* O; int ctoff;
    template <int MODE, int LAY, bool F8> DI void body(const f32x4 (&acc)[2][2][4][2], const Unit& u, int wr, int wc, int fr, int fq) const {
        const int row0 = u.pm * BM + wr * 64 + fr, colt = (u.pn + ctoff) * BM, col0 = colt + wc * 32 + 8 * fq;
        constexpr float sc = F8 ? W8_INV : 1.0f, nl2 = -1.4426950408889634f * sc;
#pragma unroll
        for (int ai = 0; ai < 2; ++ai)
#pragma unroll
            for (int m = 0; m < 4; ++m) { bf16_t* sp = O + pn_stripe((size_t)(row0 + ai * HALF + m * 16));
#pragma unroll
                for (int bj = 0; bj < 2; ++bj) { float v[8]; const int c0 = col0 + bj * HALF;
#pragma unroll
                    for (int j = 0; j < 8; ++j) { const float a = acc[ai][bj][m][j >> 2][j & 3];
                        if constexpr (MODE == 0) v[j] = (F8 ? a * sc : a) * __builtin_amdgcn_rcpf(1.0f + __builtin_amdgcn_exp2f(a * nl2));
                        else if constexpr (MODE == 1) v[j] = a * (QSCALE * sc);
                        else if constexpr (MODE == 2) v[j] = F8 ? a * sc : a;
                        else v[j] = __builtin_amdgcn_rcpf(1.0f + __builtin_amdgcn_exp2f(a * nl2)); }
                    u32x4 w; w.x = cvt_pk_bf16(v[0], v[1]); w.y = cvt_pk_bf16(v[2], v[3]); w.z = cvt_pk_bf16(v[4], v[5]); w.w = cvt_pk_bf16(v[6], v[7]);
                    if constexpr (LAY == 1) *(u32x4*)(sp + (c0 >> 5) * 512 + ((((c0 & 31) >> 3) * 16 + fr) * 8)) = w;
                    else if constexpr (LAY == 0) { const int gg = (c0 & 15) >> 2, hf = (c0 >> 4) & 1; bf16_t* bp = sp + (c0 >> 5) * 512 + hf * 4;
                        *(uint2*)(bp + (gg * 16 + fr) * 8) = make_uint2(w.x, w.y); *(uint2*)(bp + ((gg + 1) * 16 + fr) * 8) = make_uint2(w.z, w.w); }
                    else { const int gg = (c0 & 15) >> 2; bf16_t* bp = sp + (c0 >> 4) * 256 + fr * 4;
                        *(uint2*)(bp + gg * 64) = make_uint2(w.x, w.y); *(uint2*)(bp + (gg + 1) * 64) = make_uint2(w.z, w.w); } } }
    }
    DI void operator()(const f32x4 (&acc)[2][2][4][2], const Unit& u, int wr, int wc, int fr, int fq) const {
        if constexpr (GATES) { const int colt = __builtin_amdgcn_readfirstlane((u.pn + ctoff) * BM);
            if (colt < N_AK) body<1, 1, true>(acc, u, wr, wc, fr, fq); else if (colt < N_GA) body<2, 1, true>(acc, u, wr, wc, fr, fq); else body<3, 2, true>(acc, u, wr, wc, fr, fq); }
        else { const int colt = __builtin_amdgcn_readfirstlane((u.pn + ctoff) * BM);
            if (colt < N_G) body<0, 0, false>(acc, u, wr, wc, fr, fq); else if (colt < N_AQ) body<0, 2, false>(acc, u, wr, wc, fr, fq);
            else if (colt < N_AK) body<1, 1, false>(acc, u, wr, wc, fr, fq); else body<2, 1, false>(acc, u, wr, wc, fr, fq); }
    }
};
template <bool ISG> struct EpiTrMk {
    static constexpr bool PERM = true, AFTER_DRAIN = false, INIT_ACC = false;
    bf16_t* O; const float* lbf; const float* lbb; int rtoff;
    DI void operator()(const f32x4 (&acc)[2][2][4][2], const Unit& u, int wr, int wc, int fr, int fq) const {
        const int pmr = u.pm + rtoff, row0 = pmr * BM + wr * 64 + fr, col0 = u.pn * BM + wc * 32 + 8 * fq;
        float lbv[2][4];
        if constexpr (ISG) { const float* tb = pmr < 4 ? lbf : lbb;
#pragma unroll
            for (int ai = 0; ai < 2; ++ai)
#pragma unroll
                for (int m = 0; m < 4; ++m) { const int c = (row0 + ai * HALF + m * 16) & 1023; lbv[ai][m] = __builtin_amdgcn_rcpf(1.0f + __builtin_amdgcn_exp2f((tb[1024 + c] - tb[c]) * 1.4426950408889634f)); } }
#pragma unroll
        for (int ai = 0; ai < 2; ++ai)
#pragma unroll
            for (int m = 0; m < 4; ++m) { const int row = row0 + ai * HALF + m * 16;
                const float lb = ISG ? lbv[ai][m] : 0.f, omlb = 1.0f - lb;
#pragma unroll
                for (int bj = 0; bj < 2; ++bj) { float v[8]; const int t0 = col0 + bj * HALF;
#pragma unroll
                    for (int j = 0; j < 8; ++j) { const float a = acc[ai][bj][m][j >> 2][j & 3];
                        if constexpr (ISG) v[j] = 0.6931471805599453f * __builtin_amdgcn_logf(lb + omlb * __builtin_amdgcn_rcpf(1.0f + __builtin_amdgcn_exp2f(a * (-1.4426950408889634f * W8_INV))));
                        else v[j] = a; }
                    u32x4 w; w.x = cvt_pk_bf16(v[0], v[1]); w.y = cvt_pk_bf16(v[2], v[3]); w.z = cvt_pk_bf16(v[4], v[5]); w.w = cvt_pk_bf16(v[6], v[7]);
                    bf16_t* bp = O + ptb_blk(row, t0);
                    if constexpr (ISG) *(u32x4*)(bp + ((((t0 & 31) >> 3) * 16 + fr) * 8)) = w;
                    else { const int gg = (t0 & 15) >> 2, hf = (t0 >> 4) & 1;
                        *(uint2*)(bp + (gg * 16 + fr) * 8 + hf * 4) = make_uint2(w.x, w.y); *(uint2*)(bp + ((gg + 1) * 16 + fr) * 8 + hf * 4) = make_uint2(w.z, w.w); } } }
    }
};
struct EpiResidMk {
    static constexpr bool PERM = true, AFTER_DRAIN = false, INIT_ACC = true;
    const float* x; bf16_t* h;
    DI void init_acc(f32x4 (&acc)[2][2][4][2], const Unit& u, int wr, int wc, int fr, int fq) const {
        const int row0 = u.pm * BM + wr * 64 + fr, col0 = u.pn * BM + wc * 32 + 8 * fq;
#pragma unroll
        for (int ai = 0; ai < 2; ++ai)
#pragma unroll
            for (int m = 0; m < 4; ++m) { const size_t off = (size_t)(row0 + ai * HALF + m * 16) * D + col0;
#pragma unroll
                for (int bj = 0; bj < 2; ++bj)
#pragma unroll
                    for (int n = 0; n < 2; ++n) acc[ai][bj][m][n] = *(const f32x4*)(x + off + bj * HALF + n * 4); }
    }
    DI void operator()(const f32x4 (&acc)[2][2][4][2], const Unit& u, int wr, int wc, int fr, int fq) const {
        const int row0 = u.pm * BM + wr * 64 + fr, col0 = u.pn * BM + wc * 32 + 8 * fq;
#pragma unroll
        for (int ai = 0; ai < 2; ++ai)
#pragma unroll
            for (int m = 0; m < 4; ++m) { const size_t off = (size_t)(row0 + ai * HALF + m * 16) * D + col0;
#pragma unroll
                for (int bj = 0; bj < 2; ++bj) { const f32x4 a = acc[ai][bj][m][0], b = acc[ai][bj][m][1];
                    u32x4 w; w.x = cvt_pk_bf16(a[0], a[1]); w.y = cvt_pk_bf16(a[2], a[3]); w.z = cvt_pk_bf16(b[0], b[1]); w.w = cvt_pk_bf16(b[2], b[3]);
                    *(u32x4*)(h + off + bj * HALF) = w; } }
    }
};
struct EpiSwigluMk {
    static constexpr bool PERM = true, AFTER_DRAIN = false, INIT_ACC = false;
    unsigned char* O; const float* bias;
    DI void operator()(const f32x4 (&acc)[2][2][4][2], const Unit& u, int wr, int wc, int fr, int fq) const {
        const int e = u.pn >> 3, ct = u.pn & 7, row0 = u.pm * BM + wr * 64 + fr, ffc0 = ct * 128 + wc * 32 + 8 * fq;
        const float* bgp = bias + (size_t)e * 2048 + ffc0; const float* bup = bgp + 1024;
        const f32x4 bg0 = *(const f32x4*)bgp, bg1 = *(const f32x4*)(bgp + 4), bu0 = *(const f32x4*)bup, bu1 = *(const f32x4*)(bup + 4);
#pragma unroll
        for (int ai = 0; ai < 2; ++ai)
#pragma unroll
            for (int m = 0; m < 4; ++m) { int w[2] = {0, 0};
#pragma unroll
                for (int n = 0; n < 2; ++n) { const f32x4 bg = n ? bg1 : bg0, bu = n ? bu1 : bu0; float v[4];
#pragma unroll
                    for (int j = 0; j < 4; ++j) { float g = acc[ai][0][m][n][j] * W8_INV + bg[j], uu = acc[ai][1][m][n][j] * W8_INV + bu[j];
                        g = fminf(g, SW_LIM); uu = fminf(fmaxf(uu, -SW_LIM), SW_LIM); v[j] = g * fsig(SW_ALPHA * g) * (uu + 1.0f); }
                    w[n] = __builtin_amdgcn_cvt_pk_fp8_f32(v[0], v[1], w[n], false); w[n] = __builtin_amdgcn_cvt_pk_fp8_f32(v[2], v[3], w[n], true); }
                *(uint2*)(O + (size_t)(row0 + ai * HALF + m * 16) * FF + ffc0) = make_uint2((unsigned)w[0], (unsigned)w[1]); }
    }
};
struct EpiDownMk {
    static constexpr bool PERM = true, AFTER_DRAIN = false, INIT_ACC = false;
    unsigned char* O; const float* bias;
    DI void operator()(const f32x4 (&acc)[2][2][4][2], const Unit& u, int wr, int wc, int fr, int fq) const {
        const int e = u.pn >> 2, ct = u.pn & 3, row0 = u.pm * BM + wr * 64 + fr, col0 = ct * BM + wc * 32 + 8 * fq;
        const float* bp = bias + (size_t)e * D + col0; const f32x4 q0 = *(const f32x4*)bp, q1 = *(const f32x4*)(bp + 4), q2 = *(const f32x4*)(bp + HALF), q3 = *(const f32x4*)(bp + HALF + 4);
#pragma unroll
        for (int bj = 0; bj < 2; ++bj) { float b[8];
#pragma unroll
            for (int j = 0; j < 8; ++j) b[j] = bj ? (j < 4 ? q2[j & 3] : q3[j & 3]) : (j < 4 ? q0[j & 3] : q1[j & 3]);
#pragma unroll
            for (int ai = 0; ai < 2; ++ai)
#pragma unroll
                for (int m = 0; m < 4; ++m) { float v[8];
#pragma unroll
                    for (int j = 0; j < 8; ++j) v[j] = acc[ai][bj][m][j >> 2][j & 3] * W8_INV + b[j];
                    int w0 = 0, w1 = 0; w0 = __builtin_amdgcn_cvt_pk_fp8_f32(v[0], v[1], w0, false); w0 = __builtin_amdgcn_cvt_pk_fp8_f32(v[2], v[3], w0, true); w1 = __builtin_amdgcn_cvt_pk_fp8_f32(v[4], v[5], w1, false); w1 = __builtin_amdgcn_cvt_pk_fp8_f32(v[6], v[7], w1, true);
                    *(uint2*)(O + (size_t)(row0 + ai * HALF + m * 16) * D + col0 + bj * HALF) = make_uint2((unsigned)w0, (unsigned)w1); } }
    }
};
template <bool GATHER_> struct MoeOrder {
    static constexpr bool GATHER = GATHER_;
    const volatile PG8_LAS int* meta; int NCT, G, c; const int* elist;
    DI bool next(int i, Unit& u) const {
        const int nwg = __builtin_amdgcn_readfirstlane(meta[32]); const long L = (long)i * G + c; if (L >= nwg) return false;
        int wgid = (int)L; { const int q = nwg / NXCD, r = nwg % NXCD, xcd = wgid % NXCD, off = wgid / NXCD; wgid = (xcd < r ? xcd * (q + 1) : r * (q + 1) + (xcd - r) * q) + off; }
        const int ln_ = threadIdx.x & 63, pv_ = meta[ln_ & 31];
        const int e = (int)__popcll(__ballot(ln_ >= 1 && ln_ < 32 && pv_ <= wgid));
        const int local = wgid - __builtin_amdgcn_readfirstlane(meta[e]), nt = __builtin_amdgcn_readfirstlane(meta[80 + e]), rt = local % nt, ct = local / nt;
        u.pm = __builtin_amdgcn_readfirstlane(meta[40 + e]) + rt; u.pn = e * NCT + ct; u.e = e; u.r0 = rt * 256; u.cnt = __builtin_amdgcn_readfirstlane(meta[120 + e]); return true;
    }
    DI void gather_issue(const Unit& u, int tid, int (&tok)[2][2]) const {
#pragma unroll
        for (int i = 0; i < 2; ++i) { int R, C; stage_rc(tid * 16 + i * 8192, R, C);
#pragma unroll
            for (int h = 0; h < 2; ++h) { const int slot = u.r0 + h * HALF + R; tok[h][i] = slot < u.cnt ? elist[(size_t)u.e * 16384 + slot] : 0; } }
    }
    DI void gather_finish(const int (&tok)[2][2], int K, int tid, unsigned (&out)[2][2]) const {
#pragma unroll
        for (int i = 0; i < 2; ++i) { int R, C; stage_rc(tid * 16 + i * 8192, R, C);
#pragma unroll
            for (int h = 0; h < 2; ++h) out[h][i] = (unsigned)(tok[h][i] * K + C) * 2u; }
    }
    DI void gather_voffs(const Unit& u, int K, int tid, unsigned (&out)[2][2]) const {
#pragma unroll
        for (int i = 0; i < 2; ++i) { int R, C; stage_rc(tid * 16 + i * 8192, R, C);
#pragma unroll
            for (int h = 0; h < 2; ++h) { const int slot = u.r0 + h * HALF + R; const int tok = slot < u.cnt ? elist[(size_t)u.e * 16384 + slot] : 0; out[h][i] = (unsigned)(tok * K + C) * 2u; } }
    }
    DI void a_ready(const Unit&) const {}
    DI void done(const Unit&) const {}
};
}

constexpr int NWAVES = 8, NTHREADS = 512;
constexpr int PROBE_LO = -1, PROBE_HI = -1;
constexpr int RING_BYTES = 131072, LDSCTL_OFF = 135168, META_OFF = LDSCTL_OFF + 512, SS_OFF = LDSCTL_OFF + 2048, LDS_BYTES = 147456;
static_assert(META_OFF + 152 * 4 <= SS_OFF && SS_OFF + 1024 + 64 * 33 * 4 <= LDS_BYTES, "LDS control map");
#define LAS __attribute__((address_space(3)))
#define GAS __attribute__((address_space(1)))
typedef unsigned v4u __attribute__((ext_vector_type(4)));
typedef float f32x4 __attribute__((ext_vector_type(4)));
DI unsigned pk2(float lo, float hi) { return (unsigned)f2bf(lo) | ((unsigned)f2bf(hi) << 16); }

typedef short bf16x8 __attribute__((ext_vector_type(8)));
typedef short bf16x4 __attribute__((ext_vector_type(4)));
typedef float f32x2_t __attribute__((ext_vector_type(2)));
typedef __bf16 bf16x2_t __attribute__((ext_vector_type(2)));
#define MFMA16(a, b, c) __builtin_amdgcn_mfma_f32_16x16x32_bf16((a), (b), (c), 0, 0, 0)
constexpr float LOG2E = 1.4426950408889634f;
DI unsigned cvtpk(float lo, float hi) { f32x2_t v = {lo, hi}; bf16x2_t b = __builtin_convertvector(v, bf16x2_t); return __builtin_bit_cast(unsigned, b); }
DI bf16x8 pack_ab(const f32x4& a, const f32x4& b) { v4u w; w.x = cvtpk(a[0], a[1]); w.y = cvtpk(a[2], a[3]); w.z = cvtpk(b[0], b[1]); w.w = cvtpk(b[2], b[3]); return __builtin_bit_cast(bf16x8, w); }
DI bf16x8 cat44(bf16x4 lo, bf16x4 hi) { return __builtin_shufflevector(lo, hi, 0, 1, 2, 3, 4, 5, 6, 7); }


struct HgConst { bf16x8 F0, F1, I0, I1, ONES; };
DI HgConst hg_make_const(int lane, int dir) {
    const int c = lane & 15, g = lane >> 4; HgConst K;
#pragma unroll
    for (int j = 0; j < 8; ++j) { const int sp = 8 * g + j;
        K.F0[j] = (dir ? (sp >= c) : (sp <= c)) ? (short)0x3F80 : (short)0; K.F1[j] = (dir ? (sp >= 16 + c) : (sp <= 16 + c)) ? (short)0x3F80 : (short)0;
        K.I0[j] = (sp == c) ? (short)0x3F80 : (short)0; K.I1[j] = (sp == 16 + c) ? (short)0x3F80 : (short)0; K.ONES[j] = (short)0x3F80; }
    return K;
}
DI float fexp(float x) { return __builtin_amdgcn_exp2f(x * LOG2E); }
DI unsigned pk4_fp8(float a, float b, float c, float d) { int w = 0; w = __builtin_amdgcn_cvt_pk_fp8_f32(a, b, w, false); w = __builtin_amdgcn_cvt_pk_fp8_f32(c, d, w, true); return (unsigned)w; }
DI bf16x8 fp8x8_to_bf16(uint2 u) { const f32x2_t a = __builtin_amdgcn_cvt_pk_f32_fp8((int)u.x, false), b = __builtin_amdgcn_cvt_pk_f32_fp8((int)u.x, true), c = __builtin_amdgcn_cvt_pk_f32_fp8((int)u.y, false), d = __builtin_amdgcn_cvt_pk_f32_fp8((int)u.y, true);
    v4u w; w.x = cvtpk(a[0], a[1]); w.y = cvtpk(b[0], b[1]); w.z = cvtpk(c[0], c[1]); w.w = cvtpk(d[0], d[1]); return __builtin_bit_cast(bf16x8, w); }
constexpr f32x4 Z4 = {0.f, 0.f, 0.f, 0.f};
DI void hg_pass1(const bf16* __restrict__ PT, unsigned char* __restrict__ U, float* __restrict__ DEC, int uid, int lane, const HgConst& K, int dir) {
    const int c = lane & 15, g = lane >> 4, n = (uid >> 1) & 127, h = (uid >> 8) & 7, b = uid >> 11;
    const size_t tok0 = (size_t)b * SEQ + n * CH;
    const bf16* gp = PT + ptb_blk((dir ? R_GB : R_GF) + h * 128, (int)tok0) + lane * 8;
    const bf16* vp = PT + ptb_blk(R_V + h * 128, (int)tok0) + lane * 8;
    bf16x8 vB[8][2];
#pragma unroll
    for (int dvt = 0; dvt < 8; ++dvt)
#pragma unroll
        for (int ks = 0; ks < 2; ++ks) vB[dvt][ks] = *(const bf16x8*)(vp + (size_t)dvt * (T / 32) * 512 + ks * 512);
    unsigned char* up = U + (size_t)uid * 16384 + lane * 8;
#define P1_LOADG(dst_, dt_) do { _Pragma("unroll") for (int ks = 0; ks < 2; ++ks) dst_[ks] = *(const bf16x8*)(gp + (size_t)(dt_) * (T / 32) * 512 + ks * 512); } while (0)
#define P1_KEND(gB, dt, kA0, kA1) do { \
        f32x4 tot = MFMA16(K.ONES, gB[0], Z4); tot = MFMA16(K.ONES, gB[1], tot); \
        f32x4 ke[4]; \
        _Pragma("unroll") for (int tt = 0; tt < 4; ++tt) { \
            f32x4 cum = MFMA16((tt & 1) ? K.F1 : K.F0, gB[tt >> 1], Z4); \
            if (!dir && tt >= 2) cum = MFMA16(K.ONES, gB[0], cum); \
            if (dir && tt < 2) cum = MFMA16(K.ONES, gB[1], cum); \
            const f32x4 gt = MFMA16((tt & 1) ? K.I1 : K.I0, gB[tt >> 1], Z4); \
            _Pragma("unroll") for (int r = 0; r < 4; ++r) ke[tt][r] = (1.0f - fexp(gt[r])) * fexp(tot[r] - cum[r]); } \
        kA0 = pack_ab(ke[0], ke[1]); kA1 = pack_ab(ke[2], ke[3]); \
        if (g == 0) DEC[(size_t)uid * 128 + (dt) * 16 + c] = fexp(tot[0]); } while (0)
    bf16x8 gBa[2], gBb[2];
    P1_LOADG(gBa, 0); P1_LOADG(gBb, 1);
#pragma unroll 1
    for (int kd = 0; kd < 4; ++kd) {
        bf16x8 a0, a1, b0, b1;
        P1_KEND(gBa, 2 * kd, a0, a1);
        if (kd < 3) P1_LOADG(gBa, 2 * kd + 2);
        P1_KEND(gBb, 2 * kd + 1, b0, b1);
        if (kd < 3) P1_LOADG(gBb, 2 * kd + 3);
#pragma unroll
        for (int dvt = 0; dvt < 8; ++dvt) { f32x4 x = MFMA16(a0, vB[dvt][0], Z4); x = MFMA16(a1, vB[dvt][1], x); f32x4 y = MFMA16(b0, vB[dvt][0], Z4); y = MFMA16(b1, vB[dvt][1], y);
            *(uint2*)(up + (dvt * 4 + kd) * 512) = make_uint2(pk4_fp8(x[0], x[1], x[2], x[3]), pk4_fp8(y[0], y[1], y[2], y[3])); }
    }
#undef P1_LOADG
#undef P1_KEND
}
template <int dir> DI void hg_pass3_a(const bf16* __restrict__ PN, const bf16* __restrict__ PT, const unsigned char* __restrict__ U, int bhn, int lane, const HgConst& K, f32x4 (&keep)[4][4], LAS unsigned char* myslot) {
    const int c = lane & 15, g = lane >> 4, n = bhn & 127, h = (bhn >> 7) & 7, b = bhn >> 10; const int uid = bhn * 2 + dir;
    const size_t tok0 = (size_t)b * SEQ + n * CH;
    const bf16* gp = PT + ptb_blk((dir ? R_GB : R_GF) + h * 128, (int)tok0) + lane * 8;
    const bf16* qp = PN + pn_stripe(tok0) + ((N_Q + h * 128) >> 5) * 512 + lane * 8;
    f32x4 sc[4][4];
#pragma unroll
    for (int st = 0; st < 4; ++st)
#pragma unroll
        for (int tt = 0; tt < 4; ++tt) sc[st][tt] = Z4;
    bf16x8 qdB[4][4];
    bf16x8 gAb[2][2][2], q8b[2][4];
#define P3_LOAD_KD(buf_, kd_) do { _Pragma("unroll") for (int hf = 0; hf < 2; ++hf) _Pragma("unroll") for (int ks = 0; ks < 2; ++ks) gAb[buf_][hf][ks] = *(const bf16x8*)(gp + (size_t)(2 * (kd_) + hf) * (T / 32) * 512 + ks * 512); \
        _Pragma("unroll") for (int tt = 0; tt < 4; ++tt) q8b[buf_][tt] = *(const bf16x8*)(qp + (size_t)tt * 16 * NATW + (kd_) * 512); } while (0)
    P3_LOAD_KD(0, 0);
#pragma unroll
    for (int kd = 0; kd < 4; ++kd) {
        bf16x8 kiA[4];
        if (kd < 3) P3_LOAD_KD((kd + 1) & 1, kd + 1);
#pragma unroll
        for (int tt = 0; tt < 4; ++tt) {
            f32x4 qd[2], ki[2]; const bf16x8 q8 = q8b[kd & 1][tt];
#pragma unroll
            for (int hf = 0; hf < 2; ++hf) {
                f32x4 cum = MFMA16(gAb[kd & 1][hf][tt >> 1], (tt & 1) ? K.F1 : K.F0, Z4);
                if (!dir && tt >= 2) cum = MFMA16(gAb[kd & 1][hf][0], K.ONES, cum);
                if (dir && tt < 2) cum = MFMA16(gAb[kd & 1][hf][1], K.ONES, cum);
                const f32x4 gt = MFMA16(gAb[kd & 1][hf][tt >> 1], (tt & 1) ? K.I1 : K.I0, Z4);
#pragma unroll
                for (int r = 0; r < 4; ++r) { qd[hf][r] = bf2f((bf16)q8[hf * 4 + r]) * fexp(cum[r]); ki[hf][r] = (1.0f - fexp(gt[r])) * fexp(-cum[r]); }
            }
            qdB[tt][kd] = pack_ab(qd[0], qd[1]); kiA[tt] = pack_ab(ki[0], ki[1]);
        }
#pragma unroll
        for (int st = 0; st < 4; ++st)
#pragma unroll
            for (int tt = 0; tt < 4; ++tt) if (dir ? (st >= tt) : (st <= tt)) sc[st][tt] = MFMA16(kiA[st], qdB[tt][kd], sc[st][tt]);
        asm volatile("" ::: "memory");
    }
#undef P3_LOAD_KD
    bf16x8 sB[4][2];
#pragma unroll
    for (int tt = 0; tt < 4; ++tt) {
#pragma unroll
        for (int st = 0; st < 4; ++st)
#pragma unroll
            for (int r = 0; r < 4; ++r) { const int s_ = 16 * st + 4 * g + r, t_ = 16 * tt + c; const bool kp = dir ? (s_ >= t_) : (s_ <= t_); sc[st][tt][r] = kp ? sc[st][tt][r] : 0.f; }
        sB[tt][0] = pack_ab(sc[0][tt], sc[1][tt]); sB[tt][1] = pack_ab(sc[2][tt], sc[3][tt]);
    }
    const bf16* vp = PT + ptb_blk(R_V + h * 128, (int)tok0) + lane * 8;
    const unsigned char* sp = U + (size_t)uid * 16384 + lane * 8;
    bf16x8 vAb[2][2]; uint2 sAr[2][4];
#define P3_LOAD_DV(buf_, dvt_) do { _Pragma("unroll") for (int k2 = 0; k2 < 2; ++k2) vAb[buf_][k2] = *(const bf16x8*)(vp + (size_t)(dvt_) * (T / 32) * 512 + k2 * 512); \
        _Pragma("unroll") for (int kd = 0; kd < 4; ++kd) sAr[buf_][kd] = *(const uint2*)(sp + ((dvt_) * 4 + kd) * 512); } while (0)
    P3_LOAD_DV(0, 0);
#pragma unroll
    for (int dvt = 0; dvt < 8; ++dvt) {
        if (dvt < 7) P3_LOAD_DV((dvt + 1) & 1, dvt + 1);
        bf16x8 sA[4];
#pragma unroll
        for (int kd = 0; kd < 4; ++kd) sA[kd] = fp8x8_to_bf16(sAr[dvt & 1][kd]);
#pragma unroll
        for (int tt = 0; tt < 4; ++tt) {
            f32x4 acc = MFMA16(vAb[dvt & 1][0], sB[tt][0], Z4); acc = MFMA16(vAb[dvt & 1][1], sB[tt][1], acc);
#pragma unroll
            for (int kd = 0; kd < 4; ++kd) acc = MFMA16(sA[kd], qdB[tt][kd], acc);
            if ((dvt >> 2) == dir) keep[dvt & 3][tt] = acc;
            else *(LAS f32x4*)(myslot + ((dvt & 3) * 4 + tt) * 1024 + lane * 16) = acc;
        }
        asm volatile("" ::: "memory");
    }
#undef P3_LOAD_DV
}
DI void hg_pass3_b(int lane, f32x4 (&keep)[4][4], const LAS unsigned char* oslot, LAS float* myss) {
#pragma unroll
    for (int tt = 0; tt < 4; ++tt) { float ss = 0.f;
#pragma unroll
        for (int dq = 0; dq < 4; ++dq) { keep[dq][tt] = keep[dq][tt] + *(const LAS f32x4*)(oslot + (dq * 4 + tt) * 1024 + lane * 16);
            const f32x4 o = keep[dq][tt]; ss += (o[0] * o[0] + o[1] * o[1]) + (o[2] * o[2] + o[3] * o[3]); }
        ss += __shfl_xor(ss, 16); ss += __shfl_xor(ss, 32);
        myss[tt * 64 + lane] = ss; }
}
DI void hg_pass3_c(const bf16* __restrict__ PN, const bf16* __restrict__ YA, const float* __restrict__ gng, bf16* __restrict__ MG, int bhn, int lane, int dir, const f32x4 (&keep)[4][4], const LAS float* myss, const LAS float* oss) {
    const int c = lane & 15, g = lane >> 4, n = bhn & 127, h = (bhn >> 7) & 7, b = bhn >> 10;
    const size_t tok0 = (size_t)b * SEQ + n * CH;
#pragma unroll
    for (int tt = 0; tt < 4; ++tt) { const float rstd = rsqrtf((myss[tt * 64 + lane] + oss[tt * 64 + lane]) * (1.0f / 128.0f) + EPS);
        const size_t tok = tok0 + 16 * tt + c;
#pragma unroll
        for (int dq = 0; dq < 4; ++dq) { const int dvl = 64 * dir + 16 * dq + 4 * g, col = h * 128 + dvl;
            const bf16x4 sg = *(const bf16x4*)(PN + pn_stripe(tok) + ((N_G + col) >> 4) * 256 + lane * 4), ga = *(const bf16x4*)(PN + pn_stripe(tok) + ((N_GA + col) >> 4) * 256 + lane * 4), ya = *(const bf16x4*)(YA + ya_stripe(tok) + (col >> 4) * 256 + lane * 4);
            const f32x4 gn = *(const f32x4*)(gng + dvl); const f32x4 o = keep[dq][tt]; float m[4];
#pragma unroll
            for (int r = 0; r < 4; ++r) m[r] = bf2f((bf16)ga[r]) * (o[r] * rstd * gn[r] * bf2f((bf16)sg[r])) + bf2f((bf16)ya[r]);
            uint2 w; w.x = cvtpk(m[0], m[1]); w.y = cvtpk(m[2], m[3]); *(uint2*)(MG + tok * D + col) = w; } }
}
DI void attn_unit(const bf16* __restrict__ PN, const bf16* __restrict__ PT, const float* __restrict__ sink, bf16* __restrict__ YA, int b, int kv, int qt, int hh, int lane) {
    const int c = lane & 15, g = lane >> 4, q0 = qt * 16, t = q0 + c;
    const size_t tok = (size_t)b * SEQ + t;
    bf16x8 qf[2][2];
#pragma unroll
    for (int nt = 0; nt < 2; ++nt)
#pragma unroll
        for (int ks = 0; ks < 2; ++ks) qf[nt][ks] = *(const bf16x8*)(PN + pn_stripe(tok) + ((N_AQ + (kv * 4 + hh * 2 + nt) * 64) >> 5) * 512 + ks * 512 + lane * 8);
    float slope[2], mrun[2], lrun[2];
#pragma unroll
    for (int nt = 0; nt < 2; ++nt) { const int h = kv * 4 + hh * 2 + nt; slope[nt] = exp2f(-0.5f * (float)(h + 1)) * LOG2E; mrun[nt] = sink[h] * LOG2E; lrun[nt] = (g == 0) ? 1.0f : 0.0f; }
    f32x4 O[4][2];
#pragma unroll
    for (int mt = 0; mt < 4; ++mt)
#pragma unroll
        for (int nt = 0; nt < 2; ++nt) O[mt][nt] = (f32x4){0.f, 0.f, 0.f, 0.f};
    const bf16* Kbase = PN + (size_t)b * SEQ * NATW + ((N_AK + kv * 64) >> 5) * 512 + lane * 8;
    const bf16* Vbase = PT + ptb_blk(R_AV + kv * 64, b * SEQ) + c * 8;
    const int sb0 = q0 - WIN;
    bf16x8 kf[2][2];
#define ATT_LOADK(sb_) do { _Pragma("unroll") for (int ab = 0; ab < 2; ++ab) { int s_ = (sb_) + 16 * ab; s_ = (s_ < 0 || s_ >= SEQ) ? 0 : s_; \
        _Pragma("unroll") for (int ks = 0; ks < 2; ++ks) kf[ab][ks] = *(const bf16x8*)(Kbase + (size_t)(s_ >> 4) * 16 * NATW + ks * 512); } } while (0)
    ATT_LOADK(sb0);
#pragma unroll 1
    for (int i = 0; i < 9; ++i) {
        const int sb = sb0 + 32 * i;
        bf16x8 vf[4];
#pragma unroll
        for (int mt = 0; mt < 4; ++mt) { bf16x4 lo, hi;
            { int s4 = sb + 4 * g; s4 = (s4 >= 0 && s4 < SEQ) ? s4 : 0; lo = *(const bf16x4*)(Vbase + (size_t)mt * (T / 32) * 512 + (s4 >> 5) * 512 + ((s4 & 15) >> 2) * 128 + ((s4 >> 4) & 1) * 4); }
            { int s4 = sb + 16 + 4 * g; s4 = (s4 >= 0 && s4 < SEQ) ? s4 : 0; hi = *(const bf16x4*)(Vbase + (size_t)mt * (T / 32) * 512 + (s4 >> 5) * 512 + ((s4 & 15) >> 2) * 128 + ((s4 >> 4) & 1) * 4); }
            vf[mt] = cat44(lo, hi); }
        f32x4 Sa[2], Sb[2];
#pragma unroll
        for (int nt = 0; nt < 2; ++nt) { Sa[nt] = (f32x4){0.f, 0.f, 0.f, 0.f}; Sb[nt] = (f32x4){0.f, 0.f, 0.f, 0.f};
#pragma unroll
            for (int ks = 0; ks < 2; ++ks) { Sa[nt] = MFMA16(kf[0][ks], qf[nt][ks], Sa[nt]); Sb[nt] = MFMA16(kf[1][ks], qf[nt][ks], Sb[nt]); } }
        if (i < 8) ATT_LOADK(sb + 32);
        const int rel0 = t - (sb + 4 * g);
        bf16x8 pb[2];
        const bool interior = (i >= 1) && (i <= 7) && (sb >= 0) && (sb + 32 <= SEQ);
        const float rel0f = (float)rel0;
#pragma unroll
        for (int nt = 0; nt < 2; ++nt) {
            float va[4], vb[4]; float vmax = -INFINITY;
            if (interior) {
#pragma unroll
                for (int r = 0; r < 4; ++r) { va[r] = Sa[nt][r] - slope[nt] * fabsf(rel0f - (float)r); vb[r] = Sb[nt][r] - slope[nt] * fabsf(rel0f - (float)(16 + r)); vmax = fmaxf(vmax, fmaxf(va[r], vb[r])); }
            } else {
#pragma unroll
                for (int r = 0; r < 4; ++r) {
                    const int ra = rel0 - r, rb = rel0 - 16 - r; const int sa = t - ra, sbb = t - rb;
                    const bool oka = (ra <= WIN) && (ra >= -WIN) && (sa >= 0) && (sa < SEQ), okb = (rb <= WIN) && (rb >= -WIN) && (sbb >= 0) && (sbb < SEQ);
                    va[r] = oka ? Sa[nt][r] - slope[nt] * fabsf((float)ra) : -INFINITY; vb[r] = okb ? Sb[nt][r] - slope[nt] * fabsf((float)rb) : -INFINITY;
                    vmax = fmaxf(vmax, fmaxf(va[r], vb[r])); }
            }
            vmax = fmaxf(vmax, __shfl_xor(vmax, 16)); vmax = fmaxf(vmax, __shfl_xor(vmax, 32));
            const float mnew = fmaxf(mrun[nt], vmax), alpha = __builtin_amdgcn_exp2f(mrun[nt] - mnew);
            const bool moved = __any(mnew != mrun[nt]); mrun[nt] = mnew;
            f32x4 pa, pbv; float ps = 0.f;
#pragma unroll
            for (int r = 0; r < 4; ++r) { pa[r] = __builtin_amdgcn_exp2f(va[r] - mnew); pbv[r] = __builtin_amdgcn_exp2f(vb[r] - mnew); ps += pa[r] + pbv[r]; }
            lrun[nt] = lrun[nt] * alpha + ps;
            if (moved) {
#pragma unroll
                for (int mt = 0; mt < 4; ++mt) O[mt][nt] = O[mt][nt] * alpha; }
            pb[nt] = pack_ab(pa, pbv);
        }
#pragma unroll
        for (int mt = 0; mt < 4; ++mt)
#pragma unroll
            for (int nt = 0; nt < 2; ++nt) O[mt][nt] = MFMA16(vf[mt], pb[nt], O[mt][nt]);
    }
#undef ATT_LOADK
#pragma unroll
    for (int nt = 0; nt < 2; ++nt) { const int h = kv * 4 + hh * 2 + nt;
        float l = lrun[nt]; l += __shfl_xor(l, 16); l += __shfl_xor(l, 32); const float inv = 1.0f / l;
#pragma unroll
        for (int mt = 0; mt < 4; ++mt) { const int col = h * 64 + 16 * mt + 4 * g;
            const bf16x4 gt = *(const bf16x4*)(PN + pn_stripe(tok) + ((N_GB + col) >> 4) * 256 + lane * 4);
            const f32x4 o = O[mt][nt] * inv;
            uint2 w; w.x = cvtpk(o[0] * bf2f((bf16)gt[0]), o[1] * bf2f((bf16)gt[1])); w.y = cvtpk(o[2] * bf2f((bf16)gt[2]), o[3] * bf2f((bf16)gt[3]));
            *(uint2*)(YA + ya_stripe(tok) + (col >> 4) * 256 + lane * 4) = w; } }
}

DI void transpose_item(const float* W, int N, int K, int k0, int in_col0, bf16* WT, int out_row0, LAS float* scr, int lane) {
    float tmp_[32];
#pragma unroll
    for (int i = 0; i < 32; ++i) { const int kk = 2 * i + (lane >> 5); tmp_[i] = W[(size_t)(k0 + kk) * N + in_col0 + (lane & 31)]; }
#pragma unroll
    for (int i = 0; i < 32; ++i) { const int kk = 2 * i + (lane >> 5); scr[kk * 33 + (lane & 31)] = tmp_[i]; }
    asm volatile("s_waitcnt lgkmcnt(0)" ::: "memory");
    const int c = lane & 7;
#pragma unroll
    for (int j = 0; j < 4; ++j) { const int n = (lane >> 3) + 8 * j; const LAS float* s = scr + (8 * c) * 33 + n;
        v4u o; o.x = pk2(s[0 * 33], s[1 * 33]); o.y = pk2(s[2 * 33], s[3 * 33]); o.z = pk2(s[4 * 33], s[5 * 33]); o.w = pk2(s[6 * 33], s[7 * 33]);
        *(v4u*)(WT + (size_t)(out_row0 + n) * K + k0 + 8 * c) = o; }
    asm volatile("s_waitcnt lgkmcnt(0)" ::: "memory");
}


DI void transpose_item8(const float* W, int N, int K, int k0, int in_col0, unsigned char* WT, int out_row0, LAS float* scr, int lane) {
    float tmp_[32];
#pragma unroll
    for (int i = 0; i < 32; ++i) { const int kk = 2 * i + (lane >> 5); tmp_[i] = W[(size_t)(k0 + kk) * N + in_col0 + (lane & 31)]; }
#pragma unroll
    for (int i = 0; i < 32; ++i) { const int kk = 2 * i + (lane >> 5); scr[kk * 33 + (lane & 31)] = tmp_[i]; }
    asm volatile("s_waitcnt lgkmcnt(0)" ::: "memory");
    const int c = lane & 7;
#pragma unroll
    for (int j = 0; j < 4; ++j) { const int n = (lane >> 3) + 8 * j; const LAS float* s = scr + (8 * c) * 33 + n;
        int w0 = 0, w1 = 0;
        w0 = __builtin_amdgcn_cvt_pk_fp8_f32(s[0 * 33] * W8_SCALE, s[1 * 33] * W8_SCALE, w0, false); w0 = __builtin_amdgcn_cvt_pk_fp8_f32(s[2 * 33] * W8_SCALE, s[3 * 33] * W8_SCALE, w0, true);
        w1 = __builtin_amdgcn_cvt_pk_fp8_f32(s[4 * 33] * W8_SCALE, s[5 * 33] * W8_SCALE, w1, false); w1 = __builtin_amdgcn_cvt_pk_fp8_f32(s[6 * 33] * W8_SCALE, s[7 * 33] * W8_SCALE, w1, true);
        *(uint2*)(WT + (size_t)(out_row0 + n) * K + k0 + 8 * c) = make_uint2((unsigned)w0, (unsigned)w1); }
    asm volatile("s_waitcnt lgkmcnt(0)" ::: "memory");
}


DI void conv_issue(const float* src, int N, int lane, float (&tmp)[32]) {
    const unsigned long long a = (unsigned long long)src;
    const float* su = (const float*)(((unsigned long long)(unsigned)__builtin_amdgcn_readfirstlane((int)(a >> 32)) << 32) | (unsigned)__builtin_amdgcn_readfirstlane((int)a));
    const int Nu = __builtin_amdgcn_readfirstlane(N);
    const __amdgpu_buffer_rsrc_t rs = __builtin_amdgcn_make_buffer_rsrc((void*)su, (short)0, 64 * Nu * 4, 0x00020000);
    const int voff = ((lane >> 3) * Nu + (lane & 7) * 4) * 4;
#pragma unroll
    for (int i = 0; i < 8; ++i) { const v4u q = __builtin_amdgcn_raw_buffer_load_b128(rs, voff, 8 * i * Nu * 4, 2);
        tmp[4 * i] = __uint_as_float(q.x); tmp[4 * i + 1] = __uint_as_float(q.y); tmp[4 * i + 2] = __uint_as_float(q.z); tmp[4 * i + 3] = __uint_as_float(q.w); }
}
DI void conv_finish(const float (&tmp)[32], unsigned char* dst, int K, LAS float* scr, int lane) {
#pragma unroll
    for (int i = 0; i < 8; ++i) { const int kk = 8 * i + (lane >> 3), n4 = (lane & 7) * 4;
#pragma unroll
        for (int c = 0; c < 4; ++c) scr[kk * 33 + n4 + c] = tmp[4 * i + c]; }
    asm volatile("s_waitcnt lgkmcnt(0)" ::: "memory");
    const int c = lane & 7;
#pragma unroll
    for (int j = 0; j < 4; ++j) { const int n = (lane >> 3) + 8 * j; const LAS float* s = scr + (8 * c) * 33 + n;
        int w0 = 0, w1 = 0;
        w0 = __builtin_amdgcn_cvt_pk_fp8_f32(s[0 * 33] * W8_SCALE, s[1 * 33] * W8_SCALE, w0, false); w0 = __builtin_amdgcn_cvt_pk_fp8_f32(s[2 * 33] * W8_SCALE, s[3 * 33] * W8_SCALE, w0, true);
        w1 = __builtin_amdgcn_cvt_pk_fp8_f32(s[4 * 33] * W8_SCALE, s[5 * 33] * W8_SCALE, w1, false); w1 = __builtin_amdgcn_cvt_pk_fp8_f32(s[6 * 33] * W8_SCALE, s[7 * 33] * W8_SCALE, w1, true);
        { typedef unsigned u32x2_ __attribute__((ext_vector_type(2))); const u32x2_ o2 = {(unsigned)w0, (unsigned)w1}; __builtin_nontemporal_store(o2, (u32x2_*)(dst + (size_t)n * K + 8 * c)); } }
    asm volatile("s_waitcnt lgkmcnt(0)" ::: "memory");
}
DI void moe_item_desc(int r, const float* w_ug, const float* w_d, unsigned char* WUG, unsigned char* WD, const float*& src, int& N, unsigned char*& dst) {
    constexpr int I_UG = NE * 16 * 64;
    if (r < I_UG) { const int e = r / (16 * 64), q = r % (16 * 64), kb = q / 64, nb = q % 64; N = 2048;
        src = w_ug + (size_t)e * D * 2048 + (size_t)(kb * 64) * 2048 + wug_row_to_col(nb * 32); dst = WUG + (size_t)e * 2048 * D + (size_t)(nb * 32) * D + kb * 64; }
    else { r -= I_UG; const int e = r / (16 * 32), q = r % (16 * 32), kb = q / 32, nb = q % 32; N = D;
        src = w_d + (size_t)e * D * D + (size_t)(kb * 64) * D + nb * 32; dst = WD + (size_t)e * D * D + (size_t)(nb * 32) * D + kb * 64; }
}

DI void conv_batch4(int cit, int stride, const float* w_ug, const float* w_d, unsigned char* WUG, unsigned char* WD, LAS float* scr, int lane) {
    float t0[32], t1[32], t2[32], t3[32]; const float *s0, *s1, *s2, *s3; unsigned char *d0, *d1, *d2, *d3; int n0, n1, n2, n3;
    moe_item_desc(cit, w_ug, w_d, WUG, WD, s0, n0, d0); conv_issue(s0, n0, lane, t0);
    moe_item_desc(cit + stride, w_ug, w_d, WUG, WD, s1, n1, d1); conv_issue(s1, n1, lane, t1);
    moe_item_desc(cit + 2 * stride, w_ug, w_d, WUG, WD, s2, n2, d2); conv_issue(s2, n2, lane, t2);
    moe_item_desc(cit + 3 * stride, w_ug, w_d, WUG, WD, s3, n3, d3); conv_issue(s3, n3, lane, t3);
    conv_finish(t0, d0, D, scr, lane); conv_finish(t1, d1, D, scr, lane); conv_finish(t2, d2, D, scr, lane); conv_finish(t3, d3, D, scr, lane);
}

#define XB_TMO      128
#define XB_XCNT(j)  (256  + 64 * (j))
#define XB_XSUB(j)  (1280 + 64 * (j))
#define XB_XGEN(j)  (2304 + 64 * (j))
#define XB_TOP      3328
#define XB_TOPGEN   3392
#define XCD_BAR_WORDS 3456
#define XB_SPIN_CAP (1u << 18)

__device__ __forceinline__ unsigned xb_ld(unsigned* p)              { return __hip_atomic_load(p, __ATOMIC_RELAXED, __HIP_MEMORY_SCOPE_AGENT); }
__device__ __forceinline__ unsigned xb_add(unsigned* p, unsigned v) { return __hip_atomic_fetch_add(p, v, __ATOMIC_RELAXED, __HIP_MEMORY_SCOPE_AGENT); }
__device__ __forceinline__ unsigned xb_xcc_id() { return (unsigned)__builtin_amdgcn_s_getreg((3 << 11) | 20) & 0xFu; }
#define XB_SPIN(cond, bar) do { unsigned _sp = 0; while (cond) { __builtin_amdgcn_s_sleep(1); \
    if ((++_sp & 255u) == 0u) { if (xb_ld(&(bar)[XB_TMO])) break; if (_sp > XB_SPIN_CAP) { atomicAdd(&(bar)[XB_TMO], 1u); break; } } } } while (0)

struct XcdBarrier {
    unsigned* bar; unsigned x;
    volatile LAS unsigned* st;
};

__device__ __forceinline__ XcdBarrier xcd_barrier_post(unsigned* bar, volatile LAS unsigned* st) {
    XcdBarrier b; b.bar = bar; b.x = xb_xcc_id(); b.st = st;
    if (threadIdx.x == 0) (void)xb_add(&bar[XB_XCNT(b.x)], 1u);
    return b;
}
__device__ __forceinline__ void xcd_barrier_complete(unsigned* bar, unsigned x, unsigned& nloc, unsigned& nx) {
    const unsigned G = gridDim.x * gridDim.y * gridDim.z;
    unsigned sum, cnt, mine, sp = 0u;
    for (;;) {
        sum = 0u; cnt = 0u; mine = 0u;
#pragma unroll
        for (unsigned j = 0; j < 16; ++j) { const unsigned c = xb_ld(&bar[XB_XCNT(j)]); sum += c; cnt += (c > 0u) ? 1u : 0u; mine = (j == x) ? c : mine; }
        if (sum == G) break;
        __builtin_amdgcn_s_sleep(1);
        if ((++sp & 255u) == 0u) { if (xb_ld(&bar[XB_TMO])) break; if (sp > XB_SPIN_CAP) { atomicAdd(&bar[XB_TMO], 1u); break; } }
    }
    nloc = mine > 0u ? mine : 1u; nx = cnt > 0u ? cnt : 1u;
}

__device__ __forceinline__ void xcd_barrier(const XcdBarrier& b) {
    asm volatile("s_waitcnt vmcnt(0)" ::: "memory");
    __syncthreads();
    if (threadIdx.x == 0) {
        unsigned* bar = b.bar;
        __builtin_amdgcn_s_waitcnt(0);
        unsigned nloc = b.st[0], nx = b.st[1];
        if (nloc == 0u) { xcd_barrier_complete(bar, b.x, nloc, nx); b.st[0] = nloc; b.st[1] = nx; }
        const unsigned old = xb_add(&bar[XB_XSUB(b.x)], 1u);
        const unsigned gen = old / nloc;
        if (old + 1u == (gen + 1u) * nloc) {
            __builtin_amdgcn_fence(__ATOMIC_RELEASE, "agent");
            asm volatile("s_waitcnt vmcnt(0)" ::: "memory");
            const unsigned og = xb_add(&bar[XB_TOP], 1u);
            const unsigned tg = og / nx;
            if (og + 1u == (tg + 1u) * nx) xb_add(&bar[XB_TOPGEN], 1u);
            else XB_SPIN(xb_ld(&bar[XB_TOPGEN]) == tg, bar);
            __builtin_amdgcn_fence(__ATOMIC_ACQUIRE, "agent");
            xb_add(&bar[XB_XGEN(b.x)], 1u);
            asm volatile("s_waitcnt vmcnt(0)" ::: "memory");
        } else {
            XB_SPIN(xb_ld(&bar[XB_XGEN(b.x)]) == gen, bar);
            __builtin_amdgcn_fence(__ATOMIC_ACQUIRE, "agent");
            asm volatile("s_waitcnt vmcnt(0)" ::: "memory");
        }
    }
    __syncthreads();
}

struct Args { const float* in[16]; float* out; unsigned char* ws; int ph_lo, ph_hi, li, pad; };
__global__ void __launch_bounds__(NTHREADS, 2) mk_fwd(Args args) {
    extern __shared__ __attribute__((aligned(16))) unsigned char lds[];
    LAS unsigned char* L = (LAS unsigned char*)lds;
    const int tid = threadIdx.x, lane = tid & 63, wave = __builtin_amdgcn_readfirstlane(tid >> 6), G = gridDim.x, bx = blockIdx.x;
    const int vcu = (G % 8 == 0) ? (bx % 8) * (G / 8) + bx / 8 : bx;
    const int gw = vcu * NWAVES + wave, NGW = G * NWAVES;
    unsigned char* ws = args.ws;
    const float* x = args.in[0]; const float* g_mix = args.in[1]; const float* w_in = args.in[2]; const float* lbf = args.in[3]; const float* lbb = args.in[4];
    const float* w_out = args.in[7]; const float* w_ug = args.in[11]; const float* b_ug = args.in[12]; const float* w_d = args.in[13]; const float* b_d = args.in[14];
    unsigned* ctl = (unsigned*)(ws + WS_CTL);
    unsigned char *WUG = ws + WS_WUG, *WD = ws + WS_WD, *ACT = ws + WS_ACT;
    bf16 *WOUT = (bf16*)(ws + WS_WOUT), *WIN_ = (bf16*)(ws + WS_WIN), *XN = (bf16*)(ws + WS_XN), *PN = (bf16*)(ws + WS_PN), *PT = (bf16*)(ws + WS_PT),
         *MG = (bf16*)(ws + WS_MERGED), *YB = (bf16*)(ws + WS_YB);
    bf16* H = (bf16*)(ws + WS_H);
    int* tk_e = (int*)(ws + WS_TK); int* tk_slot = tk_e + T * 4; float* tk_gate = (float*)(tk_slot + T * 4); int* tk_dest = (int*)(tk_gate + T * 4);
    const int lo = args.ph_lo, hi = args.ph_hi;
#define IN(k) (lo <= (k) && (k) < hi)
    volatile LAS unsigned* MISC = (volatile LAS unsigned*)(L + LDSCTL_OFF);
    if (tid < 16) MISC[tid] = 0u;
    __syncthreads();
    XcdBarrier bar; bar.bar = ctl + CW_BAR + args.li * XCD_BAR_WORDS; bar.x = 0; bar.st = nullptr;
    if (hi - lo > 1) bar = xcd_barrier_post(ctl + CW_BAR + args.li * XCD_BAR_WORDS, MISC + 8);
#define BAR(k) do { if (IN(k) && IN((k) + 1)) xcd_barrier(bar); } while (0)

    if (IN(0)) {
        LAS float* scr = (LAS float*)(L + wave * 16384);
        constexpr int I_IN = 16 * (INW / 32), I_OUT = 16 * 32, NITEMS = I_IN + I_OUT;
        for (int it = gw; it < NITEMS; it += NGW) {
            int r = it;
            if (r < I_IN) { const int kb = r / (INW / 32), nb = r % (INW / 32), orow = nb * 32; const bool f8 = (orow >= NAT16 && orow < NATW + TR8);
                if (f8) transpose_item8(w_in, INW, D, kb * 64, win_row_to_col(orow), ws + WS_WIN8, orow, scr, lane); else transpose_item(w_in, INW, D, kb * 64, win_row_to_col(orow), WIN_, orow, scr, lane); continue; } r -= I_IN;
            { const int kb = r / 32, nb = r % 32; transpose_item(w_out, D, D, kb * 64, nb * 32, WOUT, nb * 32, scr, lane); }
        }
        for (int m = gw; m < T; m += NGW) {
            const f32x4* xr = (const f32x4*)(x + (size_t)m * D) + lane; const f32x4* gr = (const f32x4*)g_mix + lane;
            f32x4 v[4]; float s = 0.f;
#pragma unroll
            for (int j = 0; j < 4; ++j) { v[j] = xr[64 * j]; s += (v[j].x * v[j].x + v[j].y * v[j].y) + (v[j].z * v[j].z + v[j].w * v[j].w); }
            const float rstd = rsqrtf(wave_sum(s) * (1.0f / D) + EPS);
            unsigned long long* o8 = (unsigned long long*)(XN + (size_t)m * D) + lane;
            unsigned* o4 = (unsigned*)(ws + WS_XN8 + (size_t)m * D) + lane;
#pragma unroll
            for (int j = 0; j < 4; ++j) { const f32x4 g = gr[64 * j]; const float a0 = v[j].x * rstd * g.x, a1 = v[j].y * rstd * g.y, a2 = v[j].z * rstd * g.z, a3 = v[j].w * rstd * g.w;
                o8[64 * j] = (unsigned long long)pk2(a0, a1) | ((unsigned long long)pk2(a2, a3) << 32);
                int w = 0; w = __builtin_amdgcn_cvt_pk_fp8_f32(a0, a1, w, false); w = __builtin_amdgcn_cvt_pk_fp8_f32(a2, a3, w, true); o4[64 * j] = (unsigned)w; }
        }
    }
    BAR(0);
    if (IN(1)) {
        const bf16* XN8 = (const bf16*)(ws + WS_XN8); const unsigned char* WIN8 = ws + WS_WIN8;
        { pg8::Gemm g{XN, WIN_, T, NAT16, D}; pg8::StaticOrder S; S.init(T, NAT16, G, bx); pg8::EpiNatMk<false> E{PN, 0};
          pg8::gemm_phase<pg8::EpiNatMk<false>, pg8::StaticOrder, true, true>(L, g, S, E); }
        { pg8::Gemm g{WIN_ + (size_t)(NATW + TR8) * D, XN, TRW - TR8, T, D}; pg8::StaticOrder S; S.init(TRW - TR8, T, G, G - 1 - bx); pg8::EpiTrMk<false> E{PT, lbf, lbb, TR8 / 256};
          pg8::gemm_phase<pg8::EpiTrMk<false>, pg8::StaticOrder, true, true>(L, g, S, E); }
        { pg8::Gemm g{XN8, (const bf16*)(WIN8 + (size_t)NAT16 * D), T, NATW - NAT16, D / 2}; pg8::StaticOrder S; S.init(T, NATW - NAT16, G, bx); pg8::EpiNatMk<true> E{PN, NAT16 / 256};
          pg8::gemm_phase<pg8::EpiNatMk<true>, pg8::StaticOrder, true, true, true>(L, g, S, E); }
        { pg8::Gemm g{(const bf16*)(WIN8 + (size_t)NATW * D), XN8, TR8, T, D / 2}; pg8::StaticOrder S; S.init(TR8, T, G, bx); pg8::EpiTrMk<true> E{PT, lbf, lbb, 0};
          pg8::gemm_phase<pg8::EpiTrMk<true>, pg8::StaticOrder, true, true, true>(L, g, S, E); }
    }
    BAR(1);
    if (IN(2)) {
        const float* sink = args.in[6]; bf16* YA = (bf16*)(ws + WS_YA);
        constexpr int NU = NB * AKH * (SEQ / 16);
        LAS float* scr = (LAS float*)(L + wave * 16384);
        constexpr int I_UG = NE * 16 * 64, I_D = NE * 16 * 32, NCONV = I_UG + I_D;
        int cit = gw;
#define CONV_ITEMS(n_) do { for (int q_ = 0; q_ < (n_) && cit < NCONV; q_ += 4) { \
            if (cit + 3 * NGW < NCONV) { conv_batch4(cit, NGW, w_ug, w_d, WUG, WD, scr, lane); cit += 4 * NGW; } \
            else { const float* s0_; unsigned char* d0_; int n0_; float t0_[32]; moe_item_desc(cit, w_ug, w_d, WUG, WD, s0_, n0_, d0_); conv_issue(s0_, n0_, lane, t0_); conv_finish(t0_, d0_, D, scr, lane); cit += NGW; } } } while (0)
        if (wave >= 4) CONV_ITEMS(8);
        for (int u = gw; u < 2 * NU; u += NGW) { const int qt = u % (SEQ / 16), hh = (u / (SEQ / 16)) & 1, kv = (u / (SEQ / 8)) % AKH, b = u / (SEQ / 8 * AKH); attn_unit(PN, PT, sink, YA, b, kv, qt, hh, lane); CONV_ITEMS(4); }
        { const int dir = wave & 1; const HgConst K = hg_make_const(lane, dir); unsigned char* U = ws + WS_U; float* DEC = (float*)(ws + WS_DEC);
          for (int i = gw >> 1; i < 2048; i += NGW / 2) { hg_pass1(PT, U, DEC, i * 2 + dir, lane, K, dir); CONV_ITEMS(4); } }
        CONV_ITEMS(1 << 30);
#undef CONV_ITEMS
    }
    BAR(2);
    if (IN(3)) {
        const unsigned char* U = ws + WS_U; unsigned char* Sst = ws + WS_OF; const float* DEC = (const float*)(ws + WS_DEC);
        for (int i = vcu * NTHREADS + tid; i < 32 * 4096; i += G * NTHREADS) {
            const int el4 = i & 4095, chain = i >> 12, dir = chain & 1, bh = chain >> 1, d4 = 32 * ((el4 >> 7) & 3) + 16 * (el4 & 1) + 4 * ((el4 >> 5) & 3);
            f32x4 st = Z4;
            const unsigned char* ub = U + (size_t)bh * 128 * 2 * 16384 + (size_t)dir * 16384 + el4 * 4; unsigned char* sb_ = Sst + (size_t)bh * 128 * 2 * 16384 + (size_t)dir * 16384 + el4 * 4; const float* db = DEC + (size_t)bh * 128 * 2 * 128 + dir * 128 + d4;
#pragma unroll 1
            for (int k0 = 0; k0 < NCH; k0 += 8) {
                unsigned u[8]; f32x4 dc[8];
#pragma unroll
                for (int j = 0; j < 8; ++j) { const int n = dir ? NCH - 1 - (k0 + j) : (k0 + j); u[j] = *(const unsigned*)(ub + (size_t)n * 2 * 16384); dc[j] = *(const f32x4*)(db + (size_t)n * 2 * 128); }
#pragma unroll
                for (int j = 0; j < 8; ++j) { const int n = dir ? NCH - 1 - (k0 + j) : (k0 + j);
                    *(unsigned*)(sb_ + (size_t)n * 2 * 16384) = pk4_fp8(st[0], st[1], st[2], st[3]);
                    const f32x2_t lo = __builtin_amdgcn_cvt_pk_f32_fp8((int)u[j], false), hi = __builtin_amdgcn_cvt_pk_f32_fp8((int)u[j], true);
                    st[0] = dc[j][0] * st[0] + lo[0]; st[1] = dc[j][1] * st[1] + lo[1]; st[2] = dc[j][2] * st[2] + hi[0]; st[3] = dc[j][3] * st[3] + hi[1]; }
            }
        }
    }
    BAR(3);
    if (IN(4)) {
        const unsigned char* U = ws + WS_OF; const bf16* YA = (const bf16*)(ws + WS_YA); const float* gng = args.in[5];
        const int dir = wave & 1, pr = wave >> 1; const HgConst K = hg_make_const(lane, dir);
        LAS unsigned char* myslot = L + pr * 32768 + dir * 16384; LAS unsigned char* oslot = L + pr * 32768 + (dir ^ 1) * 16384;
        LAS float* myss = (LAS float*)(L + SS_OFF + wave * 1024); LAS float* oss = (LAS float*)(L + SS_OFF + (wave ^ 1) * 1024);
        for (int wi = vcu; wi < 512; wi += G) { const int bhn = wi * 4 + pr;
            f32x4 keep[4][4];
            if (dir) hg_pass3_a<1>(PN, PT, U, bhn, lane, K, keep, myslot); else hg_pass3_a<0>(PN, PT, U, bhn, lane, K, keep, myslot);
            __syncthreads();
            hg_pass3_b(lane, keep, oslot, myss);
            __syncthreads();
            hg_pass3_c(PN, YA, gng, MG, bhn, lane, dir, keep, myss, oss);
            __syncthreads();
        }
    }
    BAR(4);
    if (IN(5)) {
        pg8::Gemm g{MG, WOUT, T, D, D}; pg8::StaticOrder S; S.init(T, D, G, bx); pg8::EpiResidMk E{x, H};
        pg8::gemm_phase<pg8::EpiResidMk, pg8::StaticOrder, true, true>(L, g, S, E);
    }
    BAR(5);
    if (IN(6)) {
        const float* g_ffn = args.in[8]; const float* w_r = args.in[9]; const float* b_r = args.in[10];
        unsigned char* XN2 = ws + WS_XN2; int* elist = (int*)(ws + WS_XG);
        LAS float* WrT = (LAS float*)L; constexpr int WP = 1028;
        { f32x4 wq[16]; float gk[16];
#pragma unroll
          for (int q = 0; q < 16; ++q) { const int i4 = tid + q * NTHREADS; wq[q] = ((const f32x4*)w_r)[i4]; gk[q] = g_ffn[i4 >> 3]; }
#pragma unroll
          for (int q = 0; q < 16; ++q) { const int i4 = tid + q * NTHREADS, k = i4 >> 3, e = (i4 & 7) * 4;
#pragma unroll
              for (int t = 0; t < 4; ++t) WrT[(e + t) * WP + k] = wq[q][t] * gk[q]; } }
        volatile LAS int* lcnt = (volatile LAS int*)(L + META_OFF);
        LAS int* asg = (LAS int*)(L + SS_OFF);
        LAS float* lg = (LAS float*)(L + SS_OFF + 1024);
        const int c = lane & 15, g = lane >> 4, mt = wave >> 1, nt = wave & 1;
        for (int blk = vcu; blk < T / 64; blk += G) {
            if (tid < 32) lcnt[tid] = 0;
            __syncthreads();
            v4u hq[8][2];
#pragma unroll
            for (int rr = 0; rr < 8; ++rr) { const v4u* hr = (const v4u*)(H + (size_t)(blk * 64 + wave * 8 + rr) * D) + lane; hq[rr][0] = hr[0]; hq[rr][1] = hr[64]; }
#pragma unroll
            for (int rr = 0; rr < 8; ++rr) { const int row = blk * 64 + wave * 8 + rr;
                const f32x4* gr = (const f32x4*)g_ffn + 2 * lane;
                f32x4 v[4]; float ssq = 0.f;
#pragma unroll
                for (int j = 0; j < 2; ++j) { const v4u q = hq[rr][j];
                    v[2 * j] = (f32x4){__uint_as_float(q.x << 16), __uint_as_float(q.x & 0xffff0000u), __uint_as_float(q.y << 16), __uint_as_float(q.y & 0xffff0000u)};
                    v[2 * j + 1] = (f32x4){__uint_as_float(q.z << 16), __uint_as_float(q.z & 0xffff0000u), __uint_as_float(q.w << 16), __uint_as_float(q.w & 0xffff0000u)}; }
#pragma unroll
                for (int j = 0; j < 4; ++j) ssq += (v[j].x * v[j].x + v[j].y * v[j].y) + (v[j].z * v[j].z + v[j].w * v[j].w);
                const float rstd = rsqrtf(wave_sum(ssq) * (1.0f / D) + EPS);
                uint2* o8 = (uint2*)(XN2 + (size_t)row * D) + lane;
#pragma unroll
                for (int j = 0; j < 2; ++j) { int w[2];
#pragma unroll
                    for (int hh = 0; hh < 2; ++hh) { const f32x4 t = v[2 * j + hh] * rstd * gr[128 * j + hh]; int ww = 0; ww = __builtin_amdgcn_cvt_pk_fp8_f32(t.x, t.y, ww, false); ww = __builtin_amdgcn_cvt_pk_fp8_f32(t.z, t.w, ww, true); w[hh] = ww; }
                    o8[64 * j] = make_uint2((unsigned)w[0], (unsigned)w[1]); } }
            { const bf16* hb = H + (size_t)(blk * 64 + 16 * mt + c) * D + 8 * g; const LAS float* wb = WrT + (16 * nt + c) * WP + 8 * g;
              f32x4 acc = Z4; float ssq = 0.f;
#pragma unroll 8
              for (int q = 0; q < 32; ++q) { const v4u aq = *(const v4u*)(hb + 32 * q); const f32x4 b0 = *(const LAS f32x4*)(wb + 32 * q), b1 = *(const LAS f32x4*)(wb + 32 * q + 4);
                  const f32x4 a0 = {__uint_as_float(aq.x << 16), __uint_as_float(aq.x & 0xffff0000u), __uint_as_float(aq.y << 16), __uint_as_float(aq.y & 0xffff0000u)};
                  const f32x4 a1 = {__uint_as_float(aq.z << 16), __uint_as_float(aq.z & 0xffff0000u), __uint_as_float(aq.w << 16), __uint_as_float(aq.w & 0xffff0000u)};
                  ssq += ((a0.x * a0.x + a0.y * a0.y) + (a0.z * a0.z + a0.w * a0.w)) + ((a1.x * a1.x + a1.y * a1.y) + (a1.z * a1.z + a1.w * a1.w));
                  acc = __builtin_amdgcn_mfma_f32_16x16x4f32(a0.x, b0.x, acc, 0, 0, 0); acc = __builtin_amdgcn_mfma_f32_16x16x4f32(a0.y, b0.y, acc, 0, 0, 0);
                  acc = __builtin_amdgcn_mfma_f32_16x16x4f32(a0.z, b0.z, acc, 0, 0, 0); acc = __builtin_amdgcn_mfma_f32_16x16x4f32(a0.w, b0.w, acc, 0, 0, 0);
                  acc = __builtin_amdgcn_mfma_f32_16x16x4f32(a1.x, b1.x, acc, 0, 0, 0); acc = __builtin_amdgcn_mfma_f32_16x16x4f32(a1.y, b1.y, acc, 0, 0, 0);
                  acc = __builtin_amdgcn_mfma_f32_16x16x4f32(a1.z, b1.z, acc, 0, 0, 0); acc = __builtin_amdgcn_mfma_f32_16x16x4f32(a1.w, b1.w, acc, 0, 0, 0); }
              ssq += __shfl_xor(ssq, 16); ssq += __shfl_xor(ssq, 32);
              const float rstd = rsqrtf(ssq * (1.0f / D) + EPS); const float bias = b_r[16 * nt + c];
#pragma unroll
              for (int r = 0; r < 4; ++r) { const float rs = __shfl(rstd, 4 * g + r); lg[(16 * mt + 4 * g + r) * 33 + 16 * nt + c] = acc[r] * rs + bias; } }
            __syncthreads();
            if (tid < 64) { const int row = blk * 64 + tid; float lv[32];
#pragma unroll
                for (int e = 0; e < 32; ++e) lv[e] = lg[tid * 33 + e];
                float tv[4]; int te[4];
#pragma unroll
                for (int k = 0; k < 4; ++k) { float m = -INFINITY; int mi = 0;
#pragma unroll
                    for (int e = 0; e < 32; ++e) { const bool used = (k > 0 && te[0] == e) || (k > 1 && te[1] == e) || (k > 2 && te[2] == e); if (!used && lv[e] > m) { m = lv[e]; mi = e; } }
                    tv[k] = m; te[k] = mi; }
                const float e1 = __expf(tv[1] - tv[0]), e2 = __expf(tv[2] - tv[0]), e3 = __expf(tv[3] - tv[0]); const float inv = 1.0f / (1.0f + e1 + e2 + e3);
                const float gts[4] = {inv, e1 * inv, e2 * inv, e3 * inv};
#pragma unroll
                for (int k = 0; k < 4; ++k) { tk_e[row * 4 + k] = te[k]; tk_gate[row * 4 + k] = gts[k];
                    const int ls = __hip_atomic_fetch_add((LAS int*)(L + META_OFF) + te[k], 1, __ATOMIC_RELAXED, __HIP_MEMORY_SCOPE_WORKGROUP); asg[tid * 4 + k] = (te[k] << 16) | ls; } }
            __syncthreads();
            if (tid < 32) lcnt[32 + tid] = (int)atomicAdd(&ctl[CW_CNT + tid * CNT_STRIDE], (unsigned)lcnt[tid]);
            __syncthreads();
            if (tid < 256) { const int pk = asg[tid], e_ = pk >> 16, gs = lcnt[32 + e_] + (pk & 0xffff); tk_slot[blk * 256 + tid] = gs; elist[(size_t)e_ * 16384 + gs] = blk * 64 + (tid >> 2); }
            __syncthreads();
        }
    }
    if (IN(6) && IN(8)) xcd_barrier(bar);
#define MOE_META(NCT_) do { __syncthreads(); \
        if (tid == 0) { int uo = 0, tb = 0; for (int e = 0; e < NE; ++e) { const int nt = (int)((__hip_atomic_load(ctl + CW_CNT + e * CNT_STRIDE, __ATOMIC_RELAXED, __HIP_MEMORY_SCOPE_AGENT) + 255u) >> 8); \
            meta[e] = uo; meta[40 + e] = tb; meta[80 + e] = nt > 0 ? nt : 1; meta[120 + e] = (int)__hip_atomic_load(ctl + CW_CNT + e * CNT_STRIDE, __ATOMIC_RELAXED, __HIP_MEMORY_SCOPE_AGENT); uo += nt * (NCT_); tb += nt; } meta[32] = uo; } \
        __syncthreads(); } while (0)
    if (IN(8)) {
        volatile LAS int* meta = (volatile LAS int*)(L + META_OFF);
        MOE_META(8);
        pg8::MoeOrder<true> S{meta, 8, G, bx, (const int*)(ws + WS_XG)}; pg8::Gemm g{(const bf16*)(ws + WS_XN2), (const bf16*)WUG, NPAD, NE * 2048, D / 2}; pg8::EpiSwigluMk E{ACT, b_ug};
        pg8::gemm_phase<pg8::EpiSwigluMk, pg8::MoeOrder<true>, true, true, true>(L, g, S, E);
    }
    BAR(8);
    if (IN(9)) {
        volatile LAS int* meta = (volatile LAS int*)(L + META_OFF);
        MOE_META(4);
        pg8::MoeOrder<false> S{meta, 4, G, bx, nullptr}; pg8::Gemm g{(const bf16*)ACT, (const bf16*)WD, NPAD, NE * D, D / 2}; pg8::EpiDownMk E{(unsigned char*)YB, b_d};
        pg8::gemm_phase<pg8::EpiDownMk, pg8::MoeOrder<false>, true, true, true>(L, g, S, E);
    }
#undef MOE_META
    BAR(9);
    if (IN(10)) {
        const float* g_fin = args.in[15];
        volatile LAS int* meta = (volatile LAS int*)(L + META_OFF);
        __syncthreads();
        if (tid == 0) { int bs = 0; for (int e = 0; e < NE; ++e) { meta[e] = bs; bs += (int)((__hip_atomic_load(ctl + CW_CNT + e * CNT_STRIDE, __ATOMIC_RELAXED, __HIP_MEMORY_SCOPE_AGENT) + 255u) & ~255u); } }
        __syncthreads();
        const f32x4* gr = (const f32x4*)g_fin + lane; f32x4 gq[4];
#pragma unroll
        for (int j = 0; j < 4; ++j) gq[j] = gr[64 * j];
        for (int base = gw * 8; base < T; base += NGW * 8) {
            int my_dest = 0; float my_gate = 0.f;
            if (lane < 32) { const int a_ = base * 4 + lane; my_dest = meta[tk_e[a_]] + tk_slot[a_]; my_gate = tk_gate[a_]; }
            uint2 hA[4], hB[4], hC[4], hD[4]; unsigned yA[4][4], yB[4][4], yC[4][4], yD[4][4]; float gA[4], gB[4], gC[4], gD[4];
#define P10_LOAD(r_, h_, y_, g_) do { _Pragma("unroll") for (int k = 0; k < 4; ++k) { const int d_ = __shfl(my_dest, (r_) * 4 + k); g_[k] = __shfl(my_gate, (r_) * 4 + k); const unsigned* yp = (const unsigned*)((const unsigned char*)YB + (size_t)d_ * D) + lane; \
                _Pragma("unroll") for (int j = 0; j < 4; ++j) y_[k][j] = yp[64 * j]; } \
            { const uint2* hr = (const uint2*)(H + (size_t)(base + (r_)) * D) + lane; _Pragma("unroll") for (int j = 0; j < 4; ++j) h_[j] = hr[64 * j]; } } while (0)
#define P10_DO(r_, h_, y_, g_) do { f32x4 v[4]; _Pragma("unroll") for (int j = 0; j < 4; ++j) v[j] = (f32x4){__uint_as_float(h_[j].x << 16), __uint_as_float(h_[j].x & 0xffff0000u), __uint_as_float(h_[j].y << 16), __uint_as_float(h_[j].y & 0xffff0000u)}; \
            _Pragma("unroll") for (int k = 0; k < 4; ++k) _Pragma("unroll") for (int j = 0; j < 4; ++j) { const int w = (int)y_[k][j]; const float gt = g_[k]; const f32x2_t lo_ = __builtin_amdgcn_cvt_pk_f32_fp8(w, false), hi_ = __builtin_amdgcn_cvt_pk_f32_fp8(w, true); \
                v[j].x += gt * lo_[0]; v[j].y += gt * lo_[1]; v[j].z += gt * hi_[0]; v[j].w += gt * hi_[1]; } \
            float ssq = 0.f; _Pragma("unroll") for (int j = 0; j < 4; ++j) ssq += (v[j].x * v[j].x + v[j].y * v[j].y) + (v[j].z * v[j].z + v[j].w * v[j].w); \
            const float rstd = rsqrtf(wave_sum(ssq) * (1.0f / D) + EPS); f32x4* orow = (f32x4*)(args.out + (size_t)(base + (r_)) * D) + lane; \
            _Pragma("unroll") for (int j = 0; j < 4; ++j) orow[64 * j] = v[j] * rstd * gq[j]; } while (0)
            P10_LOAD(0, hA, yA, gA); P10_LOAD(1, hB, yB, gB); P10_LOAD(2, hC, yC, gC); P10_LOAD(3, hD, yD, gD);
            P10_DO(0, hA, yA, gA); P10_LOAD(4, hA, yA, gA); P10_DO(1, hB, yB, gB); P10_LOAD(5, hB, yB, gB); P10_DO(2, hC, yC, gC); P10_LOAD(6, hC, yC, gC); P10_DO(3, hD, yD, gD); P10_LOAD(7, hD, yD, gD);
            P10_DO(4, hA, yA, gA); P10_DO(5, hB, yB, gB); P10_DO(6, hC, yC, gC); P10_DO(7, hD, yD, gD);
#undef P10_LOAD
#undef P10_DO
        }
    }
#undef IN
#undef BAR
}

extern "C" void kernel_launch(void* const* d_in, const int* in_sizes, int n_in, void* d_out, int out_size, void* d_ws, size_t ws_size, hipStream_t stream) {
    if (n_in != 16 || in_sizes[0] != T * D || out_size != T * D || ws_size < WS_END) { fprintf(stderr, "kernel_launch: unexpected shapes / workspace (%zu < %zu)\n", ws_size, (size_t)WS_END); return; }
    char* ws = (char*)d_ws; float* out = (float*)d_out;
    (void)hipMemsetAsync(ws + WS_CTL, 0, 65536, stream);
    static int grid = 0;
    if (grid == 0) { int dev = 0, cus = 0, per_cu = 0; hipGetDevice(&dev); hipDeviceGetAttribute(&cus, hipDeviceAttributeMultiprocessorCount, dev);
        hipFuncSetAttribute((const void*)mk_fwd, hipFuncAttributeMaxDynamicSharedMemorySize, LDS_BYTES);
        hipOccupancyMaxActiveBlocksPerMultiprocessor(&per_cu, (const void*)mk_fwd, NTHREADS, LDS_BYTES);
        if (per_cu < 1) { fprintf(stderr, "kernel_launch: occupancy query says %d blocks/CU\n", per_cu); per_cu = 1; }
        (void)hipGetLastError(); grid = cus; }
    Args a{}; for (int i = 0; i < 16; ++i) a.in[i] = (const float*)d_in[i]; a.out = out; a.ws = (unsigned char*)d_ws;
#define MK(lo_, hi_) do { a.ph_lo = lo_; a.ph_hi = hi_; hipLaunchKernelGGL(mk_fwd, dim3(grid), dim3(NTHREADS), LDS_BYTES, stream, a); a.li++; } while (0)
    if (PROBE_LO < 0) { MK(0, 11); } else { MK(0, PROBE_HI); MK(PROBE_LO, PROBE_HI); if (PROBE_HI < 11) MK(PROBE_HI, 11); }
}
```

```cpp
#include <hip/hip_runtime.h>
#include <cstdio>
#include <cstdint>

typedef unsigned short bf16;
#define DI __device__ __forceinline__

constexpr int NB = 2, SEQ = 8192, T = NB * SEQ, D = 1024;
constexpr int HGH = 8, DK = 128, DV = 128, CH = 64, NCH = SEQ / CH;
constexpr int AQH = 16, AKH = 4, AHD = 64, WIN = 128;
constexpr int NE = 32, TOPK = 4, FF = 1024;
constexpr float EPS = 1e-5f, SW_LIM = 7.0f, SW_ALPHA = 1.702f;
constexpr int INW = 8704;
constexpr int C_HQ = 0, C_FF = 1024, C_FB = 2048, C_HI = 3072, C_HG = 4096, C_AQ = 5120, C_AK = 6144, C_AV = 6400, C_GA = 6656, C_GB = 7680;
constexpr int NATW = 5376, N_Q = 0, N_G = 1024, N_AQ = 2048, N_AK = 3072, N_GA = 3328, N_GB = 4352;
constexpr int TRW = 3328, R_GF = 0, R_GB = 1024, R_V = 2048, R_AV = 3072;
constexpr int NPAD = T * TOPK + NE * 256;
constexpr float QSCALE = 0.125f * 1.4426950408889634f;
constexpr int NAT16 = 2048, TR8 = 2048;
constexpr float W8_SCALE = 32.0f, W8_INV = 1.0f / 32.0f;

constexpr size_t MiB = 1u << 20;
constexpr size_t WS_CTL = 0;
constexpr size_t WS_WUG = 1 * MiB;
constexpr size_t WS_WD = WS_WUG + 128 * MiB;
constexpr size_t WS_WOUT = WS_WD + 64 * MiB;
constexpr size_t WS_H = WS_WOUT + 2 * MiB;
constexpr size_t WS_MERGED = WS_H + 64 * MiB;
constexpr size_t WS_TK = WS_MERGED + 32 * MiB;
constexpr size_t WS_B = WS_TK + 1 * MiB;
constexpr size_t WS_WIN = WS_B;
constexpr size_t WS_XN = WS_WIN + 17 * MiB;
constexpr size_t WS_PN = WS_XN + 32 * MiB;
constexpr size_t WS_PT = WS_PN + 168 * MiB;
constexpr size_t WS_YA = WS_PT + 104 * MiB;
constexpr size_t WS_U = WS_YA + 32 * MiB;
constexpr size_t WS_GQ = WS_U + 64 * MiB;
constexpr size_t WS_AQ8 = WS_U + 96 * MiB;
constexpr size_t WS_DEC = WS_U + 128 * MiB;
constexpr size_t WS_OF = WS_DEC + 2 * MiB;
constexpr size_t WS_WIN8 = WS_OF, WS_XN8 = WS_OF + 16 * MiB;
constexpr size_t WS_B_END = WS_OF + 128 * MiB;
constexpr size_t WS_XN2 = WS_B;
constexpr size_t WS_XG = WS_XN2 + 32 * MiB;
constexpr size_t WS_ACT = WS_XG + 144 * MiB;
constexpr size_t WS_YB = WS_ACT + 144 * MiB;
constexpr size_t WS_END = (WS_B_END > WS_YB + 144 * MiB) ? WS_B_END : (WS_YB + 144 * MiB);
static_assert(true, "");
constexpr int CW_CNT = 1024, CNT_STRIDE = 64;
constexpr int CW_BAR = 4096;
constexpr int CW_RDY = 16384;

DI float bf2f(bf16 b) { return __uint_as_float((unsigned)b << 16); }
DI bf16 f2bf(float f) { unsigned u = __float_as_uint(f); return (bf16)((u + 0x7fffu + ((u >> 16) & 1u)) >> 16); }
DI float sigmoidf_(float x) { return 1.0f / (1.0f + __expf(-x)); }
DI float wave_sum(float v) {
#pragma unroll
    for (int o = 1; o < 64; o <<= 1) v += __shfl_xor(v, o);
    return v;
}

DI int win_row_to_col(int r) {
    if (r < NATW) {
        if (r < N_G) return C_HQ + r;
        if (r < N_AQ) return C_HG + (r - N_G);
        if (r < N_AK) return C_AQ + (r - N_AQ);
        if (r < N_GA) return C_AK + (r - N_AK);
        if (r < N_GB) return C_GA + (r - N_GA);
        return C_GB + (r - N_GB);
    }
    r -= NATW;
    if (r < R_GB) return C_FF + r;
    if (r < R_V) return C_FB + (r - R_GB);
    if (r < R_AV) return C_HI + (r - R_V);
    return C_AV + (r - R_AV);
}
DI int wug_row_to_col(int p) { const int tile = p >> 8, c = p & 255; return c < 128 ? (tile * 128 + c) : (1024 + tile * 128 + (c - 128)); }

namespace pg8 {
#define PG8_LAS __attribute__((address_space(3)))
typedef unsigned short bf16_t;
typedef short bf16x8 __attribute__((ext_vector_type(8)));
typedef float f32x4 __attribute__((ext_vector_type(4)));
typedef unsigned u32x4 __attribute__((ext_vector_type(4)));
constexpr int BM = 256, BK = 64, HALF = 128, HTB = HALF * BK * 2  , STAGE_BYTES = 8 * HTB, NXCD = 8, WGM = 8;

__host__ __device__ __forceinline__ int lds_byte(int r, int c) { const int st = (r >> 4) * 2 + (c >> 5), rr = r & 15, cc = c & 31, ob = rr * 64 + cc * 2; return st * 1024 + (ob ^ (((ob >> 9) & 1) << 5)); }
__host__ __device__ __forceinline__ void stage_rc(int b, int& R, int& C) { const int st = b / 1024, sb = b % 1024, swz = sb ^ (((sb >> 9) & 1) << 5); R = (st >> 1) * 16 + swz / 64; C = (st & 1) * 32 + (swz % 64) / 2; }
__host__ __device__ __forceinline__ int perm32(int rho) { const int n = rho >> 4, i = rho & 15; return 8 * (i >> 2) + 4 * n + (i & 3); }

struct Unit { int pm, pn; int e, r0, cnt; int ord; };
struct Gemm { const bf16_t* A; const bf16_t* Bt; int M, N, K; };

struct StaticOrder {
    static constexpr bool GATHER = false; static constexpr int HAND = 0;
    int nM, nN, nwg, G, c;
    __host__ __device__ void init(int M, int N, int G_, int c_) { nM = M / BM; nN = N / BM; nwg = nM * nN; G = G_; c = c_; }
    __host__ __device__ bool next(int i, Unit& u) const {
        const long L = (long)i * G + c; if (L >= nwg) return false;
        int wgid = (int)L; { const int q = nwg / NXCD, r = nwg % NXCD, xcd = wgid % NXCD, off = wgid / NXCD; wgid = (xcd < r ? xcd * (q + 1) : r * (q + 1) + (xcd - r) * q) + off; }
        const int nig = WGM * nN, gid = wgid / nig, fm = gid * WGM, gsz = (nM - fm) < WGM ? (nM - fm) : WGM;
        u.pm = fm + ((wgid % nig) % gsz); u.pn = (wgid % nig) / gsz; return true;
    }
    __device__ __forceinline__ void a_ready(const Unit&) const {}
    __device__ __forceinline__ void done(const Unit&) const {}
};
__device__ __forceinline__ unsigned cvt_pk_bf16(float lo, float hi) {
    typedef float f2_ __attribute__((ext_vector_type(2))); typedef __bf16 b2_ __attribute__((ext_vector_type(2))); const f2_ v = {lo, hi}; return __builtin_bit_cast(unsigned, __builtin_convertvector(v, b2_)); }
template <class Epi, class Sched, bool ALIGN_EPI = false, bool SP2 = false, bool FP8 = false>
__device__ __forceinline__ void gemm_phase(PG8_LAS unsigned char* lds, const Gemm g, const Sched& S, const Epi& E) {
    const int tid = threadIdx.x, wid = __builtin_amdgcn_readfirstlane(tid >> 6), lane = tid & 63, wr = wid >> 2, wc = wid & 3, fr = lane & 15, fq = lane >> 4;
    const int K = g.K, nt = K / BK;
    unsigned voffA[2], voffB[2];
    unsigned gv[2][2], gvn[2][2];
#pragma unroll
    for (int i = 0; i < 2; ++i) { int R, C; stage_rc(tid * 16 + i * 8192, R, C); const int Rb = Epi::PERM ? ((R & ~31) + perm32(R & 31)) : R;
        voffA[i] = (unsigned)(R * K + C) * 2u; voffB[i] = (unsigned)(Rb * K + C) * 2u; }
    const size_t kstep = (size_t)(BK * 2);
    const size_t hstep = (size_t)HALF * K * 2;
    const size_t tstep = 2 * hstep;
    const unsigned ldsw = (unsigned)wid * 1024u;
    const int aoff = lds_byte(wr * 64 + fr, fq * 8), boff = lds_byte(wc * 32 + fr, fq * 8);
#define PG8_SA(b, h) (((b) * 2 + (h)) * HTB)
#define PG8_SB(b, h) ((4 + (b) * 2 + (h)) * HTB)
#define PG8_STAGE(bufoff, gbase, voff) do { _Pragma("unroll") for (int _i = 0; _i < 2; ++_i) \
        __builtin_amdgcn_global_load_lds((const unsigned*)((const char*)(gbase) + (voff)[_i]), (PG8_LAS unsigned*)(lds + (bufoff) + ldsw + _i * 8192), 16, 0, 0); } while (0)
#define PG8_LDA(dst, b, h) do { if constexpr (FP8) { _Pragma("unroll") for (int m = 0; m < 4; ++m) { const v4i_ lo_ = *(const PG8_LAS v4i_*)(lds + PG8_SA(b, h) + aoff + m * 2048), hi_ = *(const PG8_LAS v4i_*)(lds + PG8_SA(b, h) + aoff + m * 2048 + 1024); dst##8[m] = __builtin_shufflevector(lo_, hi_, 0, 1, 2, 3, 4, 5, 6, 7); } } \
        else { _Pragma("unroll") for (int m = 0; m < 4; ++m) _Pragma("unroll") for (int k = 0; k < 2; ++k) dst[m][k] = *(const PG8_LAS bf16x8*)(lds + PG8_SA(b, h) + aoff + m * 2048 + k * 1024); } } while (0)
#define PG8_LDB(dst, b, h) do { if constexpr (FP8) { _Pragma("unroll") for (int n = 0; n < 2; ++n) { const v4i_ lo_ = *(const PG8_LAS v4i_*)(lds + PG8_SB(b, h) + boff + n * 2048), hi_ = *(const PG8_LAS v4i_*)(lds + PG8_SB(b, h) + boff + n * 2048 + 1024); dst##8[n] = __builtin_shufflevector(lo_, hi_, 0, 1, 2, 3, 4, 5, 6, 7); } } \
        else { _Pragma("unroll") for (int n = 0; n < 2; ++n) _Pragma("unroll") for (int k = 0; k < 2; ++k) dst[n][k] = *(const PG8_LAS bf16x8*)(lds + PG8_SB(b, h) + boff + n * 2048 + k * 1024); } } while (0)
#define PG8_MMA(ai, bj, At, Bt) do { __builtin_amdgcn_s_setprio(1); _Pragma("unroll") for (int m = 0; m < 4; ++m) _Pragma("unroll") for (int n = 0; n < 2; ++n) { \
        if constexpr (FP8) asm volatile("v_mfma_scale_f32_16x16x128_f8f6f4 %0, %1, %2, %0, %3, %3 op_sel_hi:[0,0,0]" : "+v"(acc[ai][bj][m][n]) : "v"(Bt##8[n]), "v"(At##8[m]), "v"(one_scale));   \
        else { _Pragma("unroll") for (int k = 0; k < 2; ++k) acc[ai][bj][m][n] = __builtin_amdgcn_mfma_f32_16x16x32_bf16(Bt[n][k], At[m][k], acc[ai][bj][m][n], 0, 0, 0); } } \
        __builtin_amdgcn_s_setprio(0); } while (0)
#define PG8_WAIT_V(n) asm volatile("s_waitcnt vmcnt(" #n ")" ::: "memory")
#define PG8_WAIT_L(n) asm volatile("s_waitcnt lgkmcnt(" #n ")" ::: "memory")
#define PG8_BAR __builtin_amdgcn_s_barrier()
#define PG8_SCHED __builtin_amdgcn_sched_barrier(0)
    Unit cur, nxt, nn, prevu; int ui = 0;
    if (!S.next(0, cur)) return;
    prevu = cur;
    bool has_next = S.next(1, nxt);
    f32x4 acc[2][2][4][2];
#pragma unroll
    for (int a = 0; a < 2; ++a)
#pragma unroll
        for (int b = 0; b < 2; ++b)
#pragma unroll
            for (int m = 0; m < 4; ++m)
#pragma unroll
                for (int n = 0; n < 2; ++n) { typedef float f32x2z_ __attribute__((ext_vector_type(2))); f32x2z_ zl_, zh_;
                        asm volatile("v_mov_b64 %0, 0" : "=v"(zl_)); asm volatile("v_mov_b64 %0, 0" : "=v"(zh_)); acc[a][b][m][n] = __builtin_shufflevector(zl_, zh_, 0, 1, 2, 3); }
    if constexpr (Epi::INIT_ACC) E.init_acc(acc, cur, wr, wc, fr, fq);
    typedef int v8i_ __attribute__((ext_vector_type(8))); typedef int v4i_ __attribute__((ext_vector_type(4)));
    int one_scale = 0x7f7f7f7f; asm volatile("" : "+v"(one_scale));
    bf16x8 At[4][2], B0[2][2], B1[2][2]; v8i_ At8[4], B08[2], B18[2];
    const char* cA = (const char*)g.A + (Sched::GATHER ? (size_t)0 : (size_t)cur.pm * tstep); const char* cB = (const char*)g.Bt + (size_t)cur.pn * tstep;
    if constexpr (Sched::GATHER) { S.gather_voffs(cur, K, tid, gv); if (has_next) S.gather_voffs(nxt, K, tid, gvn); }
#define PG8_STAGEA(bufoff, ptr, h, nx) do { if constexpr (Sched::GATHER) { const unsigned sel_[2] = {(nx) ? gvn[h][0] : gv[h][0], (nx) ? gvn[h][1] : gv[h][1]}; PG8_STAGE(bufoff, ptr, sel_); } \
        else { PG8_STAGE(bufoff, (ptr) + (h) * hstep, voffA); } } while (0)
    S.a_ready(cur);
    if constexpr (SP2) {
        PG8_STAGE(PG8_SB(0, 0), cB, voffB); PG8_STAGE(PG8_SB(0, 1), cB + hstep, voffB); PG8_STAGEA(PG8_SA(0, 0), cA, 0, false); PG8_STAGEA(PG8_SA(0, 1), cA, 1, false);
        if (wr == 1) PG8_BAR;
        PG8_WAIT_V(2); PG8_BAR;
        PG8_STAGE(PG8_SB(1, 0), cB + kstep, voffB); PG8_STAGEA(PG8_SA(1, 0), cA + kstep, 0, false); PG8_STAGE(PG8_SB(1, 1), cB + hstep + kstep, voffB);
        PG8_WAIT_V(6); PG8_BAR;
    } else {
        PG8_STAGE(PG8_SB(0, 0), cB, voffB); PG8_STAGE(PG8_SA(0, 0), cA, voffA); PG8_STAGE(PG8_SB(0, 1), cB + hstep, voffB); PG8_STAGE(PG8_SA(0, 1), cA + hstep, voffA);
        if (wr == 1) PG8_BAR;
        PG8_WAIT_V(4); PG8_BAR;
        PG8_STAGE(PG8_SB(1, 0), cB + kstep, voffB); PG8_STAGE(PG8_SA(1, 0), cA + kstep, voffA); PG8_STAGE(PG8_SB(1, 1), cB + hstep + kstep, voffB);
        PG8_WAIT_V(6); PG8_BAR;
    }
    for (;;) {
        const char* nA = has_next ? (const char*)g.A + (Sched::GATHER ? (size_t)0 : (size_t)nxt.pm * tstep) : cA; const char* nB = has_next ? (const char*)g.Bt + (size_t)nxt.pn * tstep : cB;
#pragma unroll 1
        for (int t = 0; t < nt; t += 2) {
            const bool last = (t == nt - 2); const bool nx = last && has_next;
            const char* a1 = cA + (size_t)(t + 1) * kstep;
            const char* a2 = last ? nA : cA + (size_t)(t + 2) * kstep; const char* b2 = last ? nB : cB + (size_t)(t + 2) * kstep;
            const char* a3 = a2 + kstep; const char* b3 = b2 + kstep;
            if (last && has_next) S.a_ready(nxt);
            if constexpr (SP2) {
            PG8_LDB(B0, 0, 0); PG8_LDB(B1, 0, 1); PG8_SCHED; PG8_LDA(At, 0, 0); PG8_STAGEA(PG8_SA(1, 1), a1, 1, false);
            PG8_WAIT_V(8); PG8_WAIT_L(0); PG8_BAR; PG8_MMA(0, 0, At, B0); PG8_MMA(0, 1, At, B1); PG8_BAR; PG8_SCHED;
            PG8_LDA(At, 0, 1); PG8_STAGE(PG8_SB(0, 0), b2, voffB); PG8_STAGE(PG8_SB(0, 1), b2 + hstep, voffB); PG8_STAGEA(PG8_SA(0, 0), a2, 0, nx);
            PG8_WAIT_V(8); PG8_WAIT_L(0); PG8_BAR; PG8_MMA(1, 0, At, B0); PG8_MMA(1, 1, At, B1); PG8_BAR; PG8_SCHED;
            PG8_LDB(B0, 1, 0); PG8_LDB(B1, 1, 1); PG8_SCHED; PG8_LDA(At, 1, 0); PG8_STAGEA(PG8_SA(0, 1), a2, 1, nx);
            PG8_WAIT_V(8); PG8_WAIT_L(0); PG8_BAR; PG8_MMA(0, 0, At, B0); PG8_MMA(0, 1, At, B1); PG8_BAR; PG8_SCHED;
            PG8_LDA(At, 1, 1); PG8_STAGE(PG8_SB(1, 0), b3, voffB); PG8_STAGE(PG8_SB(1, 1), b3 + hstep, voffB); PG8_STAGEA(PG8_SA(1, 0), a3, 0, nx);
            PG8_WAIT_V(8); PG8_WAIT_L(0); PG8_BAR; PG8_MMA(1, 0, At, B0); PG8_MMA(1, 1, At, B1); PG8_BAR; PG8_SCHED;
            } else {
            PG8_LDB(B0, 0, 0); PG8_SCHED; PG8_LDA(At, 0, 0); PG8_STAGE(PG8_SA(1, 1), a1 + hstep, voffA);
            PG8_WAIT_L(8); PG8_BAR; PG8_WAIT_L(0); PG8_MMA(0, 0, At, B0); PG8_BAR; PG8_SCHED;
            PG8_LDB(B1, 0, 1); PG8_STAGE(PG8_SB(0, 0), b2, voffB);
            PG8_BAR; PG8_WAIT_L(0); PG8_MMA(0, 1, At, B1); PG8_BAR;
            PG8_LDA(At, 0, 1); PG8_STAGE(PG8_SA(0, 0), a2, voffA);
            PG8_BAR; PG8_WAIT_L(0); PG8_MMA(1, 0, At, B0); PG8_BAR; PG8_SCHED;
            PG8_STAGE(PG8_SB(0, 1), b2 + hstep, voffB);
            PG8_WAIT_V(6); PG8_BAR; PG8_MMA(1, 1, At, B1); PG8_BAR;
            PG8_LDB(B0, 1, 0); PG8_SCHED; PG8_LDA(At, 1, 0); PG8_STAGE(PG8_SA(0, 1), a2 + hstep, voffA);
            PG8_WAIT_L(8); PG8_BAR; PG8_WAIT_L(0); PG8_MMA(0, 0, At, B0); PG8_BAR; PG8_SCHED;
            PG8_LDB(B1, 1, 1); PG8_STAGE(PG8_SB(1, 0), b3, voffB);
            PG8_BAR; PG8_WAIT_L(0); PG8_MMA(0, 1, At, B1); PG8_BAR;
            PG8_LDA(At, 1, 1); PG8_STAGE(PG8_SA(1, 0), a3, voffA);
            PG8_BAR; PG8_WAIT_L(0); PG8_MMA(1, 0, At, B0); PG8_BAR; PG8_SCHED;
            PG8_STAGE(PG8_SB(1, 1), b3 + hstep, voffB);
            PG8_WAIT_V(6); PG8_BAR; PG8_MMA(1, 1, At, B1); PG8_BAR;
            }
        }
        if constexpr (FP8) asm volatile("s_nop 15\n\ts_nop 15" ::: "memory");
        else asm volatile("s_nop 15" ::: "memory");
        if constexpr (ALIGN_EPI) { if (wr == 0) PG8_BAR; }
        if constexpr (Sched::HAND == 1) { if (ui > 0) S.publish(prevu); }
        bool has_nn = false; int gtok[2][2]; unsigned rdyv = 0u;
        if (has_next) { has_nn = S.next(ui + 2, nn); if constexpr (Sched::GATHER) { if (has_nn) S.gather_issue(nn, tid, gtok); }
            if constexpr (Sched::HAND == 2) { if (has_nn && wid == 0) rdyv = S.ready_load(nn); } }
        if constexpr (!Epi::AFTER_DRAIN) { E(acc, cur, wr, wc, fr, fq); S.done(cur); }
        if constexpr (Sched::HAND == 2) { if (has_nn && wid == 0) S.ready_commit(nn, rdyv); }
        if (!has_next) break;
        prevu = cur;
#pragma unroll
        for (int a = 0; a < 2; ++a)
#pragma unroll
            for (int b = 0; b < 2; ++b)
#pragma unroll
                for (int m = 0; m < 4; ++m)
#pragma unroll
                    for (int n = 0; n < 2; ++n) { typedef float f32x2z_ __attribute__((ext_vector_type(2))); f32x2z_ zl_, zh_;
                        asm volatile("v_mov_b64 %0, 0" : "=v"(zl_)); asm volatile("v_mov_b64 %0, 0" : "=v"(zh_)); acc[a][b][m][n] = __builtin_shufflevector(zl_, zh_, 0, 1, 2, 3); }
        if constexpr (Epi::INIT_ACC) E.init_acc(acc, nxt, wr, wc, fr, fq);
        cur = nxt; cA = nA; cB = nB; ++ui;
        if constexpr (Sched::GATHER) { gv[0][0] = gvn[0][0]; gv[0][1] = gvn[0][1]; gv[1][0] = gvn[1][0]; gv[1][1] = gvn[1][1]; if (has_nn) S.gather_finish(gtok, K, tid, gvn); }
        nxt = nn; has_next = has_nn;
        if constexpr (ALIGN_EPI) { if (wr == 1) PG8_BAR; }
    }
    PG8_WAIT_V(0);
    if constexpr (Sched::HAND == 1) S.publish(cur);
    if constexpr (!ALIGN_EPI) { if (wr == 0) PG8_BAR; }
    PG8_BAR;
    if constexpr (Epi::AFTER_DRAIN) { E.fused(acc, cur, wr, wc, fr, fq, lds, wid, lane); S.done(cur); }
#undef PG8_SA
#undef PG8_SB
#undef PG8_STAGE
#undef PG8_STAGEA
#undef PG8_LDA
#undef PG8_LDB
#undef PG8_MMA
#undef PG8_WAIT_V
#undef PG8_WAIT_L
#undef PG8_BAR
#undef PG8_SCHED
}
}

DI size_t ptb_blk(int f, int t) { return ((size_t)(f >> 4) * (T / 32) + (t >> 5)) * 512; }
DI size_t pn_stripe(size_t tok) { return (tok >> 4) * (size_t)(16 * NATW); }
DI size_t ya_stripe(size_t tok) { return (tok >> 4) * (size_t)(16 * D); }
namespace pg8 {
typedef float f32x2 __attribute__((ext_vector_type(2)));
DI float fsig(float x) { return __builtin_amdgcn_rcpf(1.0f + __expf(-x)); }
template <bool GATES> struct EpiNatMk {
    static constexpr bool PERM = true, AFTER_DRAIN = false, INIT_ACC = false;
    bf16_t* O; int ctoff; unsigned char* GQ; unsigned char* AQ;
    template <int MODE, int LAY, bool F8> DI void body(const f32x4 (&acc)[2][2][4][2], const Unit& u, int wr, int wc, int fr, int fq) const {
        const int row0 = u.pm * BM + wr * 64 + fr, colt = (u.pn + ctoff) * BM, col0 = colt + wc * 32 + 8 * fq;
        constexpr float sc = F8 ? W8_INV : 1.0f, nl2 = -1.4426950408889634f * sc;
#pragma unroll
        for (int ai = 0; ai < 2; ++ai)
#pragma unroll
            for (int m = 0; m < 4; ++m) { bf16_t* sp = O + pn_stripe((size_t)(row0 + ai * HALF + m * 16));
#pragma unroll
                for (int bj = 0; bj < 2; ++bj) { float v[8]; const int c0 = col0 + bj * HALF;
#pragma unroll
                    for (int j = 0; j < 8; j += 2) { const f32x2 a = {acc[ai][bj][m][j >> 2][j & 3], acc[ai][bj][m][j >> 2][(j & 3) + 1]}; f32x2 o;
                        if constexpr (MODE == 0 || MODE == 3) { const f32x2 t = a * nl2; f32x2 d; d.x = __builtin_amdgcn_exp2f(t.x); d.y = __builtin_amdgcn_exp2f(t.y); d = d + 1.0f;
                            f32x2 r; r.x = __builtin_amdgcn_rcpf(d.x); r.y = __builtin_amdgcn_rcpf(d.y); o = MODE == 0 ? (F8 ? a * sc : a) * r : (LAY == 3 ? r * 255.0f + 0.5f : r); }
                        else if constexpr (MODE == 1) o = a * (QSCALE * sc);
                        else o = F8 ? a * sc : a;
                        v[j] = o.x; v[j + 1] = o.y; }
                    if constexpr (LAY == 3) { unsigned lo = 0, hi = 0;
#pragma unroll
                        for (int j = 0; j < 4; ++j) { lo = __builtin_amdgcn_cvt_pk_u8_f32(v[j], j, lo); hi = __builtin_amdgcn_cvt_pk_u8_f32(v[4 + j], j, hi); }
                        *(uint2*)(GQ + ((size_t)(row0 + ai * HALF + m * 16) >> 4) * 32768 + ((c0 - N_GA) >> 4) * 256 + fr * 16 + (c0 & 15)) = make_uint2(lo, hi); continue; }
                    if constexpr (LAY == 4) { int w0 = 0, w1 = 0; w0 = __builtin_amdgcn_cvt_pk_fp8_f32(v[0], v[1], w0, false); w0 = __builtin_amdgcn_cvt_pk_fp8_f32(v[2], v[3], w0, true); w1 = __builtin_amdgcn_cvt_pk_fp8_f32(v[4], v[5], w1, false); w1 = __builtin_amdgcn_cvt_pk_fp8_f32(v[6], v[7], w1, true);
                        *(uint2*)(AQ + ((size_t)(row0 + ai * HALF + m * 16) >> 4) * 16384 + ((c0 - N_AQ) >> 5) * 512 + ((((c0 & 31) >> 3) * 16 + fr) * 8)) = make_uint2((unsigned)w0, (unsigned)w1); continue; }
                    u32x4 w; w.x = cvt_pk_bf16(v[0], v[1]); w.y = cvt_pk_bf16(v[2], v[3]); w.z = cvt_pk_bf16(v[4], v[5]); w.w = cvt_pk_bf16(v[6], v[7]);
                    if constexpr (LAY == 1) *(u32x4*)(sp + (c0 >> 5) * 512 + ((((c0 & 31) >> 3) * 16 + fr) * 8)) = w;
                    else if constexpr (LAY == 0) { const int gg = (c0 & 15) >> 2, hf = (c0 >> 4) & 1; bf16_t* bp = sp + (c0 >> 5) * 512 + hf * 4;
                        *(uint2*)(bp + (gg * 16 + fr) * 8) = make_uint2(w.x, w.y); *(uint2*)(bp + ((gg + 1) * 16 + fr) * 8) = make_uint2(w.z, w.w); }
                    else { const int gg = (c0 & 15) >> 2; bf16_t* bp = sp + (c0 >> 4) * 256 + fr * 4;
                        *(uint2*)(bp + gg * 64) = make_uint2(w.x, w.y); *(uint2*)(bp + (gg + 1) * 64) = make_uint2(w.z, w.w); } } }
    }
    DI void operator()(const f32x4 (&acc)[2][2][4][2], const Unit& u, int wr, int wc, int fr, int fq) const {
        if constexpr (GATES) { const int colt = __builtin_amdgcn_readfirstlane((u.pn + ctoff) * BM);
            if (colt < N_AK) body<1, 4, true>(acc, u, wr, wc, fr, fq); else if (colt < N_GA) body<2, 1, true>(acc, u, wr, wc, fr, fq); else body<3, 3, true>(acc, u, wr, wc, fr, fq); }
        else { const int colt = __builtin_amdgcn_readfirstlane((u.pn + ctoff) * BM);
            if (colt < N_G) body<0, 0, false>(acc, u, wr, wc, fr, fq); else if (colt < N_AQ) body<0, 2, false>(acc, u, wr, wc, fr, fq);
            else if (colt < N_AK) body<1, 1, false>(acc, u, wr, wc, fr, fq); else body<2, 1, false>(acc, u, wr, wc, fr, fq); }
    }
};
template <bool ISG> struct EpiTrMk {
    static constexpr bool PERM = true, AFTER_DRAIN = false, INIT_ACC = false;
    bf16_t* O; const float* lbf; const float* lbb; int rtoff;
    DI void operator()(const f32x4 (&acc)[2][2][4][2], const Unit& u, int wr, int wc, int fr, int fq) const {
        const int pmr = u.pm + rtoff, row0 = pmr * BM + wr * 64 + fr, col0 = u.pn * BM + wc * 32 + 8 * fq;
        float lbv[2][4];
        if constexpr (ISG) { const float* tb = pmr < 4 ? lbf : lbb;
#pragma unroll
            for (int ai = 0; ai < 2; ++ai)
#pragma unroll
                for (int m = 0; m < 4; ++m) { const int c = (row0 + ai * HALF + m * 16) & 1023; lbv[ai][m] = __builtin_amdgcn_rcpf(1.0f + __builtin_amdgcn_exp2f((tb[1024 + c] - tb[c]) * 1.4426950408889634f)); } }
#pragma unroll
        for (int ai = 0; ai < 2; ++ai)
#pragma unroll
            for (int m = 0; m < 4; ++m) { const int row = row0 + ai * HALF + m * 16;
                const float lb = ISG ? lbv[ai][m] : 0.f, omlb = 1.0f - lb;
                const float qs = ISG ? 255.0f * __builtin_amdgcn_rcpf(fminf(__builtin_amdgcn_logf(lb), -1e-6f)) : 0.f;
#pragma unroll
                for (int bj = 0; bj < 2; ++bj) { float v[8]; const int t0 = col0 + bj * HALF;
#pragma unroll
                    for (int j = 0; j < 8; j += 2) { const f32x2 a = {acc[ai][bj][m][j >> 2][j & 3], acc[ai][bj][m][j >> 2][(j & 3) + 1]};
                        if constexpr (ISG) { const f32x2 t = a * (-1.4426950408889634f * W8_INV); f32x2 d; d.x = __builtin_amdgcn_exp2f(t.x); d.y = __builtin_amdgcn_exp2f(t.y); d = d + 1.0f;
                            f32x2 r; r.x = __builtin_amdgcn_rcpf(d.x); r.y = __builtin_amdgcn_rcpf(d.y); const f32x2 f = r * omlb + lb; f32x2 l; l.x = __builtin_amdgcn_logf(f.x); l.y = __builtin_amdgcn_logf(f.y);
                            l = l * qs + 0.5f; v[j] = l.x; v[j + 1] = l.y; }
                        else { v[j] = a.x; v[j + 1] = a.y; } }
                    if constexpr (ISG) { unsigned lo = 0, hi = 0;
#pragma unroll
                        for (int j = 0; j < 4; ++j) { lo = __builtin_amdgcn_cvt_pk_u8_f32(v[j], j, lo); hi = __builtin_amdgcn_cvt_pk_u8_f32(v[4 + j], j, hi); }
                        *(uint2*)((unsigned char*)O + ptb_blk(row, t0) + ((((t0 & 31) >> 3) * 16 + fr) * 8)) = make_uint2(lo, hi); continue; }
                    u32x4 w; w.x = cvt_pk_bf16(v[0], v[1]); w.y = cvt_pk_bf16(v[2], v[3]); w.z = cvt_pk_bf16(v[4], v[5]); w.w = cvt_pk_bf16(v[6], v[7]);
                    bf16_t* bp = O + ptb_blk(row, t0);
                    { const int gg = (t0 & 15) >> 2, hf = (t0 >> 4) & 1;
                        *(uint2*)(bp + (gg * 16 + fr) * 8 + hf * 4) = make_uint2(w.x, w.y); *(uint2*)(bp + ((gg + 1) * 16 + fr) * 8 + hf * 4) = make_uint2(w.z, w.w); } } }
    }
};
struct EpiResidMk {
    static constexpr bool PERM = true, AFTER_DRAIN = false, INIT_ACC = true;
    const float* x; bf16_t* h;
    DI void init_acc(f32x4 (&acc)[2][2][4][2], const Unit& u, int wr, int wc, int fr, int fq) const {
        const int row0 = u.pm * BM + wr * 64 + fr, col0 = u.pn * BM + wc * 32 + 8 * fq;
#pragma unroll
        for (int ai = 0; ai < 2; ++ai)
#pragma unroll
            for (int m = 0; m < 4; ++m) { const size_t off = (size_t)(row0 + ai * HALF + m * 16) * D + col0;
#pragma unroll
                for (int bj = 0; bj < 2; ++bj)
#pragma unroll
                    for (int n = 0; n < 2; ++n) acc[ai][bj][m][n] = *(const f32x4*)(x + off + bj * HALF + n * 4) * W8_SCALE; }
    }
    DI void operator()(const f32x4 (&acc)[2][2][4][2], const Unit& u, int wr, int wc, int fr, int fq) const {
        const int row0 = u.pm * BM + wr * 64 + fr, col0 = u.pn * BM + wc * 32 + 8 * fq;
#pragma unroll
        for (int ai = 0; ai < 2; ++ai)
#pragma unroll
            for (int m = 0; m < 4; ++m) { const size_t off = (size_t)(row0 + ai * HALF + m * 16) * D + col0;
#pragma unroll
                for (int bj = 0; bj < 2; ++bj) { const f32x4 a = acc[ai][bj][m][0] * W8_INV, b = acc[ai][bj][m][1] * W8_INV;
                    u32x4 w; w.x = cvt_pk_bf16(a[0], a[1]); w.y = cvt_pk_bf16(a[2], a[3]); w.z = cvt_pk_bf16(b[0], b[1]); w.w = cvt_pk_bf16(b[2], b[3]);
                    *(u32x4*)(h + off + bj * HALF) = w; } }
    }
};
struct EpiSwigluMk {
    static constexpr bool PERM = true, AFTER_DRAIN = false, INIT_ACC = false;
    unsigned char* O; const float* bias;
    DI void operator()(const f32x4 (&acc)[2][2][4][2], const Unit& u, int wr, int wc, int fr, int fq) const {
        const int e = u.pn >> 3, ct = u.pn & 7, row0 = u.pm * BM + wr * 64 + fr, ffc0 = ct * 128 + wc * 32 + 8 * fq;
        const float* bgp = bias + (size_t)e * 2048 + ffc0; const float* bup = bgp + 1024;
        const f32x4 bg0 = *(const f32x4*)bgp, bg1 = *(const f32x4*)(bgp + 4), bu0 = *(const f32x4*)bup, bu1 = *(const f32x4*)(bup + 4);
#pragma unroll
        for (int ai = 0; ai < 2; ++ai)
#pragma unroll
            for (int m = 0; m < 4; ++m) { int w[2] = {0, 0};
#pragma unroll
                for (int n = 0; n < 2; ++n) { const f32x4 bg = n ? bg1 : bg0, bu = n ? bu1 : bu0; f32x2 v[2];
#pragma unroll
                    for (int p2 = 0; p2 < 2; ++p2) { const f32x4 ag = acc[ai][0][m][n], au = acc[ai][1][m][n];
                        f32x2 g = (f32x2){ag[2 * p2], ag[2 * p2 + 1]} * W8_INV + (f32x2){bg[2 * p2], bg[2 * p2 + 1]}, uu = (f32x2){au[2 * p2], au[2 * p2 + 1]} * W8_INV + (f32x2){bu[2 * p2], bu[2 * p2 + 1]};
                        g.x = fminf(g.x, SW_LIM); g.y = fminf(g.y, SW_LIM); uu.x = __builtin_amdgcn_fmed3f(uu.x, -SW_LIM, SW_LIM); uu.y = __builtin_amdgcn_fmed3f(uu.y, -SW_LIM, SW_LIM);
                        const f32x2 t = g * (-SW_ALPHA * 1.4426950408889634f); f32x2 d; d.x = __builtin_amdgcn_exp2f(t.x); d.y = __builtin_amdgcn_exp2f(t.y); d = d + 1.0f;
                        f32x2 r; r.x = __builtin_amdgcn_rcpf(d.x); r.y = __builtin_amdgcn_rcpf(d.y);
                        const f32x2 gl = g * r; v[p2] = uu * gl + gl; }
                    w[n] = __builtin_amdgcn_cvt_pk_fp8_f32(v[0].x, v[0].y, w[n], false); w[n] = __builtin_amdgcn_cvt_pk_fp8_f32(v[1].x, v[1].y, w[n], true); }
                __hip_atomic_store((unsigned long long*)(O + (size_t)(row0 + ai * HALF + m * 16) * FF + ffc0), (unsigned long long)(unsigned)w[0] | ((unsigned long long)(unsigned)w[1] << 32), __ATOMIC_RELAXED, __HIP_MEMORY_SCOPE_AGENT); }
    }
};
struct EpiDownMk {
    static constexpr bool PERM = true, AFTER_DRAIN = false, INIT_ACC = false;
    unsigned char* O; const float* bias;
    DI void operator()(const f32x4 (&acc)[2][2][4][2], const Unit& u, int wr, int wc, int fr, int fq) const {
        const int e = u.pn >> 2, ct = u.pn & 3, row0 = u.pm * BM + wr * 64 + fr, col0 = ct * BM + wc * 32 + 8 * fq;
        const float* bp = bias + (size_t)e * D + col0; const f32x4 q0 = *(const f32x4*)bp, q1 = *(const f32x4*)(bp + 4), q2 = *(const f32x4*)(bp + HALF), q3 = *(const f32x4*)(bp + HALF + 4);
#pragma unroll
        for (int bj = 0; bj < 2; ++bj) { float b[8];
#pragma unroll
            for (int j = 0; j < 8; ++j) b[j] = bj ? (j < 4 ? q2[j & 3] : q3[j & 3]) : (j < 4 ? q0[j & 3] : q1[j & 3]);
#pragma unroll
            for (int ai = 0; ai < 2; ++ai)
#pragma unroll
                for (int m = 0; m < 4; ++m) { float v[8];
#pragma unroll
                    for (int j = 0; j < 8; j += 2) { const f32x2 o = (f32x2){acc[ai][bj][m][j >> 2][j & 3], acc[ai][bj][m][j >> 2][(j & 3) + 1]} * W8_INV + (f32x2){b[j], b[j + 1]}; v[j] = o.x; v[j + 1] = o.y; }
                    int w0 = 0, w1 = 0; w0 = __builtin_amdgcn_cvt_pk_fp8_f32(v[0], v[1], w0, false); w0 = __builtin_amdgcn_cvt_pk_fp8_f32(v[2], v[3], w0, true); w1 = __builtin_amdgcn_cvt_pk_fp8_f32(v[4], v[5], w1, false); w1 = __builtin_amdgcn_cvt_pk_fp8_f32(v[6], v[7], w1, true);
                    *(uint2*)(O + (size_t)(row0 + ai * HALF + m * 16) * D + col0 + bj * HALF) = make_uint2((unsigned)w0, (unsigned)w1); } }
    }
};
template <bool GATHER_> struct MoeOrder {
    static constexpr bool GATHER = GATHER_; static constexpr int HAND = GATHER_ ? 1 : 2;
    const volatile PG8_LAS int* meta; int NCT, G, c; const int* elist; unsigned* ready; volatile PG8_LAS int* flags; unsigned* tmo;
    DI bool next(int i, Unit& u) const {
        const int nwg = __builtin_amdgcn_readfirstlane(meta[32]); const long L = (long)i * G + c; if (L >= nwg) return false;
        int wgid = (int)L; { const int q = nwg / NXCD, r = nwg % NXCD, xcd = wgid % NXCD, off = wgid / NXCD; wgid = (xcd < r ? xcd * (q + 1) : r * (q + 1) + (xcd - r) * q) + off; }
        const int ln_ = threadIdx.x & 63, pv_ = meta[ln_ & 31];
        const int e = (int)__popcll(__ballot(ln_ >= 1 && ln_ < 32 && pv_ <= wgid));
        const int local = wgid - __builtin_amdgcn_readfirstlane(meta[e]), rt = local / NCT, ct = local % NCT;
        u.pm = __builtin_amdgcn_readfirstlane(meta[40 + e]) + rt; u.pn = e * NCT + ct; u.e = e; u.r0 = rt * 256; u.cnt = __builtin_amdgcn_readfirstlane(meta[120 + e]); u.ord = i; return true;
    }
    DI void gather_issue(const Unit& u, int tid, int (&tok)[2][2]) const {
#pragma unroll
        for (int i = 0; i < 2; ++i) { int R, C; stage_rc(tid * 16 + i * 8192, R, C);
#pragma unroll
            for (int h = 0; h < 2; ++h) { const int slot = u.r0 + h * HALF + R; tok[h][i] = slot < u.cnt ? elist[(size_t)u.e * 16384 + slot] : 0; } }
    }
    DI void gather_finish(const int (&tok)[2][2], int K, int tid, unsigned (&out)[2][2]) const {
#pragma unroll
        for (int i = 0; i < 2; ++i) { int R, C; stage_rc(tid * 16 + i * 8192, R, C);
#pragma unroll
            for (int h = 0; h < 2; ++h) out[h][i] = (unsigned)(tok[h][i] * K + C) * 2u; }
    }
    DI void gather_voffs(const Unit& u, int K, int tid, unsigned (&out)[2][2]) const {
#pragma unroll
        for (int i = 0; i < 2; ++i) { int R, C; stage_rc(tid * 16 + i * 8192, R, C);
#pragma unroll
            for (int h = 0; h < 2; ++h) { const int slot = u.r0 + h * HALF + R; const int tok = slot < u.cnt ? elist[(size_t)u.e * 16384 + slot] : 0; out[h][i] = (unsigned)(tok * K + C) * 2u; } }
    }
    static constexpr unsigned NEED = 8u * 8u;
    DI void publish(const Unit& u) const { if ((threadIdx.x & 63) == 0) (void)__hip_atomic_fetch_add(ready + 16 * u.pm, 1u, __ATOMIC_RELAXED, __HIP_MEMORY_SCOPE_AGENT); }
    DI unsigned ready_load(const Unit& u) const { return __hip_atomic_load(ready + 16 * u.pm, __ATOMIC_RELAXED, __HIP_MEMORY_SCOPE_AGENT); }
    DI void ready_commit(const Unit& u, unsigned v) const { if ((threadIdx.x & 63) == 0) flags[u.ord & 3] = (v >= NEED) ? 1 : 0; }
    DI void a_ready(const Unit& u) const {
        if constexpr (!GATHER_) {
            if (flags[u.ord & 3] != 0) return;
            if (threadIdx.x < 64) { unsigned sp = 0;
                while ((unsigned)__builtin_amdgcn_readfirstlane(__hip_atomic_load(ready + 16 * u.pm, __ATOMIC_RELAXED, __HIP_MEMORY_SCOPE_AGENT)) < NEED) {
                    __builtin_amdgcn_s_sleep(2);
                    if ((++sp & 255u) == 0u) { if (__builtin_amdgcn_readfirstlane(__hip_atomic_load(tmo, __ATOMIC_RELAXED, __HIP_MEMORY_SCOPE_AGENT)) != 0u) break; if (sp > (1u << 18)) { if (threadIdx.x == 0) atomicAdd(tmo, 1u); break; } } } }
            asm volatile("" ::: "memory"); __builtin_amdgcn_s_barrier(); asm volatile("" ::: "memory");
        }
    }
    DI void done(const Unit&) const {}
};
}

constexpr int NWAVES = 8, NTHREADS = 512;
constexpr int P8_LO = 256, NP8 = 0;
constexpr int PRE_NB = 1, PRE_LO = 64, PRE_HI = 192, NPRE = (PRE_HI - PRE_LO) * NWAVES * 4 * PRE_NB;
constexpr int PROBE_LO = -1, PROBE_HI = -1;
constexpr int RING_BYTES = 131072, LDSCTL_OFF = 135168, META_OFF = LDSCTL_OFF + 512, SS_OFF = LDSCTL_OFF + 2048, LDS_BYTES = 147456;
static_assert(META_OFF + 152 * 4 <= SS_OFF && SS_OFF + 1024 + 64 * 33 * 4 <= LDS_BYTES, "LDS control map");
#define LAS __attribute__((address_space(3)))
#define GAS __attribute__((address_space(1)))
typedef unsigned v4u __attribute__((ext_vector_type(4)));
typedef float f32x4 __attribute__((ext_vector_type(4)));
DI unsigned pk2(float lo, float hi) { return (unsigned)f2bf(lo) | ((unsigned)f2bf(hi) << 16); }

typedef short bf16x8 __attribute__((ext_vector_type(8)));
typedef short bf16x4 __attribute__((ext_vector_type(4)));
typedef float f32x2_t __attribute__((ext_vector_type(2)));
typedef __bf16 bf16x2_t __attribute__((ext_vector_type(2)));
#define MFMA16(a, b, c) __builtin_amdgcn_mfma_f32_16x16x32_bf16((a), (b), (c), 0, 0, 0)
constexpr float LOG2E = 1.4426950408889634f;
DI unsigned cvtpk(float lo, float hi) { f32x2_t v = {lo, hi}; bf16x2_t b = __builtin_convertvector(v, bf16x2_t); return __builtin_bit_cast(unsigned, b); }
DI bf16x8 pack_ab(const f32x4& a, const f32x4& b) { v4u w; w.x = cvtpk(a[0], a[1]); w.y = cvtpk(a[2], a[3]); w.z = cvtpk(b[0], b[1]); w.w = cvtpk(b[2], b[3]); return __builtin_bit_cast(bf16x8, w); }
DI bf16x8 cat44(bf16x4 lo, bf16x4 hi) { return __builtin_shufflevector(lo, hi, 0, 1, 2, 3, 4, 5, 6, 7); }


struct HgConst { bf16x8 F0, F1, I0, I1, ONES; };
DI HgConst hg_make_const(int lane, int dir) {
    const int c = lane & 15, g = lane >> 4; HgConst K;
#pragma unroll
    for (int j = 0; j < 8; ++j) { const int sp = 8 * g + j;
        K.F0[j] = (dir ? (sp >= c) : (sp <= c)) ? (short)0x3F80 : (short)0; K.F1[j] = (dir ? (sp >= 16 + c) : (sp <= 16 + c)) ? (short)0x3F80 : (short)0;
        K.I0[j] = (sp == c) ? (short)0x3F80 : (short)0; K.I1[j] = (sp == 16 + c) ? (short)0x3F80 : (short)0; K.ONES[j] = (short)0x3F80; }
    return K;
}
DI float fexp(float x) { return __builtin_amdgcn_exp2f(x * LOG2E); }
DI f32x2_t exp2_2(f32x2_t v) { f32x2_t r; r.x = __builtin_amdgcn_exp2f(v.x); r.y = __builtin_amdgcn_exp2f(v.y); return r; }
DI unsigned pk4_fp8(float a, float b, float c, float d) { int w = 0; w = __builtin_amdgcn_cvt_pk_fp8_f32(a, b, w, false); w = __builtin_amdgcn_cvt_pk_fp8_f32(c, d, w, true); return (unsigned)w; }
DI bf16x8 fp8x8_to_bf16(uint2 u) { const f32x2_t a = __builtin_amdgcn_cvt_pk_f32_fp8((int)u.x, false), b = __builtin_amdgcn_cvt_pk_f32_fp8((int)u.x, true), c = __builtin_amdgcn_cvt_pk_f32_fp8((int)u.y, false), d = __builtin_amdgcn_cvt_pk_f32_fp8((int)u.y, true);
    v4u w; w.x = cvtpk(a[0], a[1]); w.y = cvtpk(b[0], b[1]); w.z = cvtpk(c[0], c[1]); w.w = cvtpk(d[0], d[1]); return __builtin_bit_cast(bf16x8, w); }
constexpr f32x4 Z4 = {0.f, 0.f, 0.f, 0.f};
DI bf16x8 g8_deq(uint2 r, float sc) {
    const unsigned a = cvtpk((float)(r.x & 255u) * sc, (float)((r.x >> 8) & 255u) * sc), b = cvtpk((float)((r.x >> 16) & 255u) * sc, (float)(r.x >> 24) * sc);
    const unsigned c = cvtpk((float)(r.y & 255u) * sc, (float)((r.y >> 8) & 255u) * sc), d = cvtpk((float)((r.y >> 16) & 255u) * sc, (float)(r.y >> 24) * sc);
    typedef unsigned u4_ __attribute__((ext_vector_type(4))); const u4_ w = {a, b, c, d}; return __builtin_bit_cast(bf16x8, w);
}
DI void hg_pass1(const bf16* __restrict__ PT, const float* __restrict__ GS, unsigned char* __restrict__ U, float* __restrict__ DEC, int uid, int lane, const HgConst& K, int dir) {
    const int c = lane & 15, g = lane >> 4, n = (uid >> 1) & 127, h = (uid >> 8) & 7, b = uid >> 11;
    const size_t tok0 = (size_t)b * SEQ + n * CH;
    const unsigned char* gp = (const unsigned char*)PT + ptb_blk((dir ? R_GB : R_GF) + h * 128, (int)tok0) + lane * 8;
    const bf16* vp = PT + ptb_blk(R_V + h * 128, (int)tok0) + lane * 8;
    float gsc[8];
#pragma unroll
    for (int dt = 0; dt < 8; ++dt) gsc[dt] = GS[dir * 1024 + h * 128 + dt * 16 + c];
    bf16x8 vB[8][2];
#pragma unroll
    for (int dvt = 0; dvt < 8; ++dvt)
#pragma unroll
        for (int ks = 0; ks < 2; ++ks) vB[dvt][ks] = *(const bf16x8*)(vp + (size_t)dvt * (T / 32) * 512 + ks * 512);
    unsigned char* up = U + (size_t)uid * 16384 + lane * 8;
#define P1_LOADG(dst_, dt_) do { _Pragma("unroll") for (int ks = 0; ks < 2; ++ks) dst_[ks] = *(const uint2*)(gp + (size_t)(dt_) * (T / 32) * 512 + ks * 512); } while (0)
#define P1_KEND(gR, dt, kA0, kA1) do { const bf16x8 gB[2] = {g8_deq(gR[0], gsc[dt]), g8_deq(gR[1], gsc[dt])}; \
        f32x4 tot = MFMA16(K.ONES, gB[0], Z4); tot = MFMA16(K.ONES, gB[1], tot); \
        f32x4 ke[4]; \
        _Pragma("unroll") for (int tt = 0; tt < 4; ++tt) { \
            f32x4 cum = MFMA16((tt & 1) ? K.F1 : K.F0, gB[tt >> 1], Z4); \
            if (!dir && tt >= 2) cum = MFMA16(K.ONES, gB[0], cum); \
            if (dir && tt < 2) cum = MFMA16(K.ONES, gB[1], cum); \
            const f32x4 gt = MFMA16((tt & 1) ? K.I1 : K.I0, gB[tt >> 1], Z4); \
            _Pragma("unroll") for (int r = 0; r < 4; r += 2) { const f32x2_t g2 = (f32x2_t){gt[r], gt[r + 1]} * LOG2E, d2 = ((f32x2_t){tot[r], tot[r + 1]} - (f32x2_t){cum[r], cum[r + 1]}) * LOG2E; \
                const f32x2_t k2 = (1.0f - exp2_2(g2)) * exp2_2(d2); ke[tt][r] = k2.x; ke[tt][r + 1] = k2.y; } } \
        kA0 = pack_ab(ke[0], ke[1]); kA1 = pack_ab(ke[2], ke[3]); \
        if (g == 0) DEC[(size_t)uid * 128 + (dt) * 16 + c] = fexp(tot[0]); } while (0)
    uint2 gBa[2], gBb[2];
    P1_LOADG(gBa, 0); P1_LOADG(gBb, 1);
#pragma unroll 2
    for (int kd = 0; kd < 4; ++kd) {
        bf16x8 a0, a1, b0, b1;
        P1_KEND(gBa, 2 * kd, a0, a1);
        if (kd < 3) P1_LOADG(gBa, 2 * kd + 2);
        P1_KEND(gBb, 2 * kd + 1, b0, b1);
        if (kd < 3) P1_LOADG(gBb, 2 * kd + 3);
#pragma unroll
        for (int dvt = 0; dvt < 8; ++dvt) { f32x4 x = MFMA16(a0, vB[dvt][0], Z4); x = MFMA16(a1, vB[dvt][1], x); f32x4 y = MFMA16(b0, vB[dvt][0], Z4); y = MFMA16(b1, vB[dvt][1], y);
            *(uint2*)(up + (dvt * 4 + kd) * 512) = make_uint2(pk4_fp8(x[0], x[1], x[2], x[3]), pk4_fp8(y[0], y[1], y[2], y[3])); }
    }
#undef P1_LOADG
#undef P1_KEND
}
template <int dir> DI void hg_pass3_a(const bf16* __restrict__ PN, const bf16* __restrict__ PT, const float* __restrict__ GS, const unsigned char* __restrict__ U, int bhn, int lane, const HgConst& K, f32x4 (&keep)[4][4], LAS unsigned char* myslot) {
    const int c = lane & 15, g = lane >> 4, n = bhn & 127, h = (bhn >> 7) & 7, b = bhn >> 10; const int uid = bhn * 2 + dir;
    const size_t tok0 = (size_t)b * SEQ + n * CH;
    const unsigned char* gp = (const unsigned char*)PT + ptb_blk((dir ? R_GB : R_GF) + h * 128, (int)tok0) + lane * 8;
    float gsc[4][2];
#pragma unroll
    for (int kd = 0; kd < 4; ++kd)
#pragma unroll
        for (int hf = 0; hf < 2; ++hf) gsc[kd][hf] = GS[dir * 1024 + h * 128 + (2 * kd + hf) * 16 + c];
    const bf16* qp = PN + pn_stripe(tok0) + ((N_Q + h * 128) >> 5) * 512 + lane * 8;
    f32x4 sc[4][4];
#pragma unroll
    for (int st = 0; st < 4; ++st)
#pragma unroll
        for (int tt = 0; tt < 4; ++tt) sc[st][tt] = Z4;
    bf16x8 qdB[4][4];
    uint2 gAr[2][2][2]; bf16x8 q8b[2][4];
#define P3_LOAD_KD(buf_, kd_) do { _Pragma("unroll") for (int hf = 0; hf < 2; ++hf) _Pragma("unroll") for (int ks = 0; ks < 2; ++ks) gAr[buf_][hf][ks] = *(const uint2*)(gp + (size_t)(2 * (kd_) + hf) * (T / 32) * 512 + ks * 512); \
        _Pragma("unroll") for (int tt = 0; tt < 4; ++tt) q8b[buf_][tt] = *(const bf16x8*)(qp + (size_t)tt * 16 * NATW + (kd_) * 512); } while (0)
    P3_LOAD_KD(0, 0);
#pragma unroll
    for (int kd = 0; kd < 4; ++kd) {
        bf16x8 kiA[4];
        if (kd < 3) P3_LOAD_KD((kd + 1) & 1, kd + 1);
        bf16x8 gAb[2][2];
#pragma unroll
        for (int hf = 0; hf < 2; ++hf)
#pragma unroll
            for (int ks = 0; ks < 2; ++ks) gAb[hf][ks] = g8_deq(gAr[kd & 1][hf][ks], gsc[kd][hf]);
#pragma unroll
        for (int tt = 0; tt < 4; ++tt) {
            f32x4 qd[2], ki[2]; const bf16x8 q8 = q8b[kd & 1][tt];
#pragma unroll
            for (int hf = 0; hf < 2; ++hf) {
                f32x4 cum = MFMA16(gAb[hf][tt >> 1], (tt & 1) ? K.F1 : K.F0, Z4);
                if (!dir && tt >= 2) cum = MFMA16(gAb[hf][0], K.ONES, cum);
                if (dir && tt < 2) cum = MFMA16(gAb[hf][1], K.ONES, cum);
                const f32x4 gt = MFMA16(gAb[hf][tt >> 1], (tt & 1) ? K.I1 : K.I0, Z4);
#pragma unroll
                for (int r = 0; r < 4; r += 2) { const f32x2_t c2 = (f32x2_t){cum[r], cum[r + 1]} * LOG2E, g2 = (f32x2_t){gt[r], gt[r + 1]} * LOG2E;
                    const f32x2_t q2 = (f32x2_t){bf2f((bf16)q8[hf * 4 + r]), bf2f((bf16)q8[hf * 4 + r + 1])} * exp2_2(c2), k2 = (1.0f - exp2_2(g2)) * exp2_2(-c2);
                    qd[hf][r] = q2.x; qd[hf][r + 1] = q2.y; ki[hf][r] = k2.x; ki[hf][r + 1] = k2.y; }
            }
            qdB[tt][kd] = pack_ab(qd[0], qd[1]); kiA[tt] = pack_ab(ki[0], ki[1]);
        }
#pragma unroll
        for (int st = 0; st < 4; ++st)
#pragma unroll
            for (int tt = 0; tt < 4; ++tt) if (dir ? (st >= tt) : (st <= tt)) sc[st][tt] = MFMA16(kiA[st], qdB[tt][kd], sc[st][tt]);
        asm volatile("" ::: "memory");
    }
#undef P3_LOAD_KD
    bf16x8 sB[4][2];
#pragma unroll
    for (int tt = 0; tt < 4; ++tt) {
#pragma unroll
        for (int st = 0; st < 4; ++st)
#pragma unroll
            for (int r = 0; r < 4; ++r) { const int s_ = 16 * st + 4 * g + r, t_ = 16 * tt + c; const bool kp = dir ? (s_ >= t_) : (s_ <= t_); sc[st][tt][r] = kp ? sc[st][tt][r] : 0.f; }
        sB[tt][0] = pack_ab(sc[0][tt], sc[1][tt]); sB[tt][1] = pack_ab(sc[2][tt], sc[3][tt]);
    }
    const bf16* vp = PT + ptb_blk(R_V + h * 128, (int)tok0) + lane * 8;
    const unsigned char* sp = U + (size_t)uid * 16384 + lane * 8;
    bf16x8 vAb[2][2]; uint2 sAr[2][4];
#define P3_LOAD_DV(buf_, dvt_) do { _Pragma("unroll") for (int k2 = 0; k2 < 2; ++k2) vAb[buf_][k2] = *(const bf16x8*)(vp + (size_t)(dvt_) * (T / 32) * 512 + k2 * 512); \
        _Pragma("unroll") for (int kd = 0; kd < 4; ++kd) sAr[buf_][kd] = *(const uint2*)(sp + ((dvt_) * 4 + kd) * 512); } while (0)
    P3_LOAD_DV(0, 0);
#pragma unroll
    for (int dvt = 0; dvt < 8; ++dvt) {
        if (dvt < 7) P3_LOAD_DV((dvt + 1) & 1, dvt + 1);
        bf16x8 sA[4];
#pragma unroll
        for (int kd = 0; kd < 4; ++kd) sA[kd] = fp8x8_to_bf16(sAr[dvt & 1][kd]);
#pragma unroll
        for (int tt = 0; tt < 4; ++tt) {
            f32x4 acc = MFMA16(vAb[dvt & 1][0], sB[tt][0], Z4); acc = MFMA16(vAb[dvt & 1][1], sB[tt][1], acc);
#pragma unroll
            for (int kd = 0; kd < 4; ++kd) acc = MFMA16(sA[kd], qdB[tt][kd], acc);
            if ((dvt >> 2) == dir) keep[dvt & 3][tt] = acc;
            else *(LAS f32x4*)(myslot + ((dvt & 3) * 4 + tt) * 1024 + lane * 16) = acc;
        }
        asm volatile("" ::: "memory");
    }
#undef P3_LOAD_DV
}
DI void hg_pass3_b(int lane, f32x4 (&keep)[4][4], const LAS unsigned char* oslot, LAS float* myss) {
#pragma unroll
    for (int tt = 0; tt < 4; ++tt) { float ss = 0.f;
#pragma unroll
        for (int dq = 0; dq < 4; ++dq) { keep[dq][tt] = keep[dq][tt] + *(const LAS f32x4*)(oslot + (dq * 4 + tt) * 1024 + lane * 16);
            const f32x4 o = keep[dq][tt]; ss += (o[0] * o[0] + o[1] * o[1]) + (o[2] * o[2] + o[3] * o[3]); }
        ss += __shfl_xor(ss, 16); ss += __shfl_xor(ss, 32);
        myss[tt * 64 + lane] = ss; }
}
struct HgC { bf16x4 sg[4][4]; unsigned ya[4][4], ga[4][4]; };
DI void hg_pass3_c_load(const bf16* __restrict__ PN, const unsigned char* __restrict__ GQ, const bf16* __restrict__ YA, int bhn, int lane, int dir, HgC& r) {
    const int c = lane & 15, g = lane >> 4, n = bhn & 127, h = (bhn >> 7) & 7, b = bhn >> 10;
    const size_t tok0 = (size_t)b * SEQ + n * CH;
#pragma unroll
    for (int tt = 0; tt < 4; ++tt) { const size_t tok = tok0 + 16 * tt + c;
#pragma unroll
        for (int dq = 0; dq < 4; ++dq) { const int dvl = 64 * dir + 16 * dq + 4 * g, col = h * 128 + dvl;
            r.sg[tt][dq] = *(const bf16x4*)(PN + pn_stripe(tok) + ((N_G + col) >> 4) * 256 + lane * 4); r.ga[tt][dq] = *(const unsigned*)(GQ + (tok >> 4) * 32768 + (col >> 4) * 256 + c * 16 + 4 * g);
            r.ya[tt][dq] = *(const unsigned*)((const unsigned char*)YA + ya_stripe(tok) + (col >> 4) * 256 + lane * 4); } }
}
DI void hg_pass3_c(const HgC& r, const float* __restrict__ gng, bf16* __restrict__ MG, int bhn, int lane, int dir, const f32x4 (&keep)[4][4], const LAS float* myss, const LAS float* oss) {
    const int c = lane & 15, g = lane >> 4, n = bhn & 127, h = (bhn >> 7) & 7, b = bhn >> 10;
    const size_t tok0 = (size_t)b * SEQ + n * CH;
#pragma unroll
    for (int tt = 0; tt < 4; ++tt) { const float rstd = rsqrtf((myss[tt * 64 + lane] + oss[tt * 64 + lane]) * (1.0f / 128.0f) + EPS) * (1.0f / 255.0f);
        const size_t tok = tok0 + 16 * tt + c;
#pragma unroll
        for (int dq = 0; dq < 4; ++dq) { const int dvl = 64 * dir + 16 * dq + 4 * g, col = h * 128 + dvl;
            const bf16x4 sg = r.sg[tt][dq]; const unsigned gq = r.ga[tt][dq]; const f32x2_t ya01 = __builtin_amdgcn_cvt_pk_f32_fp8((int)r.ya[tt][dq], false), ya23 = __builtin_amdgcn_cvt_pk_f32_fp8((int)r.ya[tt][dq], true); const float ya[4] = {ya01[0], ya01[1], ya23[0], ya23[1]};
            const float ga[4] = {(float)(gq & 255u), (float)((gq >> 8) & 255u), (float)((gq >> 16) & 255u), (float)(gq >> 24)};
            const f32x4 gn = *(const f32x4*)(gng + dvl); const f32x4 o = keep[dq][tt]; float m[4];
#pragma unroll
            for (int q = 0; q < 4; ++q) m[q] = ga[q] * (o[q] * rstd * gn[q] * bf2f((bf16)sg[q])) + ya[q];
            int w = 0; w = __builtin_amdgcn_cvt_pk_fp8_f32(m[0], m[1], w, false); w = __builtin_amdgcn_cvt_pk_fp8_f32(m[2], m[3], w, true); *(unsigned*)((unsigned char*)MG + tok * D + col) = (unsigned)w; } }
}
DI void attn_unit(const bf16* __restrict__ PN, const unsigned char* __restrict__ AQ8, const unsigned char* __restrict__ GQ, const bf16* __restrict__ PT, const float* __restrict__ sink, bf16* __restrict__ YA, int b, int kv, int qt, int hh, int lane) {
    const int c = lane & 15, g = lane >> 4, q0 = qt * 16, t = q0 + c;
    const size_t tok = (size_t)b * SEQ + t;
    bf16x8 qf[2][2];
#pragma unroll
    for (int nt = 0; nt < 2; ++nt)
#pragma unroll
        for (int ks = 0; ks < 2; ++ks) qf[nt][ks] = fp8x8_to_bf16(*(const uint2*)(AQ8 + (tok >> 4) * 16384 + (((kv * 4 + hh * 2 + nt) * 64) >> 5) * 512 + ks * 512 + lane * 8));
    float slope[2], mrun[2], lrun[2];
#pragma unroll
    for (int nt = 0; nt < 2; ++nt) { const int h = kv * 4 + hh * 2 + nt; slope[nt] = exp2f(-0.5f * (float)(h + 1)) * LOG2E; mrun[nt] = sink[h] * LOG2E; lrun[nt] = (g == 0) ? 1.0f : 0.0f; }
    f32x4 O[4][2];
#pragma unroll
    for (int mt = 0; mt < 4; ++mt)
#pragma unroll
        for (int nt = 0; nt < 2; ++nt) O[mt][nt] = (f32x4){0.f, 0.f, 0.f, 0.f};
    const bf16* Kbase = PN + (size_t)b * SEQ * NATW + ((N_AK + kv * 64) >> 5) * 512 + lane * 8;
    const bf16* Vbase = PT + ptb_blk(R_AV + kv * 64, b * SEQ) + c * 8;
    const int sb0 = __builtin_amdgcn_readfirstlane(q0 - WIN);
    const bf16* Vl = Vbase + g * 128;
    bf16x8 kf[2][2];
#define ATT_LOADK(sb_) do { _Pragma("unroll") for (int ab = 0; ab < 2; ++ab) { int s_ = (sb_) + 16 * ab; s_ = (s_ < 0 || s_ >= SEQ) ? 0 : s_; \
        _Pragma("unroll") for (int ks = 0; ks < 2; ++ks) kf[ab][ks] = *(const bf16x8*)(Kbase + (size_t)(s_ >> 4) * 16 * NATW + ks * 512); } } while (0)
    ATT_LOADK(sb0);
#pragma unroll 3
    for (int i = 0; i < 9; ++i) {
        const int sb = sb0 + 32 * i;
        bf16x8 vf[4];
        const int sl_ = (sb >= 0 && sb < SEQ) ? sb : 0, sh_ = (sb + 16 >= 0 && sb + 16 < SEQ) ? sb + 16 : 0;
        const int ol_ = (sl_ >> 5) * 512 + ((sl_ >> 4) & 1) * 4, oh_ = (sh_ >> 5) * 512 + ((sh_ >> 4) & 1) * 4;
#pragma unroll
        for (int mt = 0; mt < 4; ++mt) { const bf16x4 lo = *(const bf16x4*)(Vl + (size_t)mt * (T / 32) * 512 + ol_), hi = *(const bf16x4*)(Vl + (size_t)mt * (T / 32) * 512 + oh_);
            vf[mt] = cat44(lo, hi); }
        f32x4 Sa[2], Sb[2];
#pragma unroll
        for (int nt = 0; nt < 2; ++nt) { Sa[nt] = (f32x4){0.f, 0.f, 0.f, 0.f}; Sb[nt] = (f32x4){0.f, 0.f, 0.f, 0.f};
#pragma unroll
            for (int ks = 0; ks < 2; ++ks) { Sa[nt] = MFMA16(kf[0][ks], qf[nt][ks], Sa[nt]); Sb[nt] = MFMA16(kf[1][ks], qf[nt][ks], Sb[nt]); } }
        if (i < 8) ATT_LOADK(sb + 32);
        const int rel0 = t - (sb + 4 * g);
        bf16x8 pb[2];
        const bool interior = (i >= 1) && (i <= 7) && (sb >= 0) && (sb + 32 <= SEQ);
        const float rel0f = (float)rel0;
#pragma unroll
        for (int nt = 0; nt < 2; ++nt) {
            float va[4], vb[4]; float vmax = -INFINITY;
            if (interior) {
#pragma unroll
                for (int r = 0; r < 4; ++r) { va[r] = Sa[nt][r] - slope[nt] * fabsf(rel0f - (float)r); vb[r] = Sb[nt][r] - slope[nt] * fabsf(rel0f - (float)(16 + r)); vmax = fmaxf(vmax, fmaxf(va[r], vb[r])); }
            } else if (sb >= 0 && sb + 32 <= SEQ) {
#pragma unroll
                for (int r = 0; r < 4; ++r) { const float ra = fabsf(rel0f - (float)r), rb = fabsf(rel0f - (float)(16 + r));
                    va[r] = ra <= (float)WIN ? Sa[nt][r] - slope[nt] * ra : -INFINITY; vb[r] = rb <= (float)WIN ? Sb[nt][r] - slope[nt] * rb : -INFINITY; vmax = fmaxf(vmax, fmaxf(va[r], vb[r])); }
            } else {
#pragma unroll
                for (int r = 0; r < 4; ++r) {
                    const int ra = rel0 - r, rb = rel0 - 16 - r; const int sa = t - ra, sbb = t - rb;
                    const bool oka = (ra <= WIN) && (ra >= -WIN) && (sa >= 0) && (sa < SEQ), okb = (rb <= WIN) && (rb >= -WIN) && (sbb >= 0) && (sbb < SEQ);
                    va[r] = oka ? Sa[nt][r] - slope[nt] * fabsf((float)ra) : -INFINITY; vb[r] = okb ? Sb[nt][r] - slope[nt] * fabsf((float)rb) : -INFINITY;
                    vmax = fmaxf(vmax, fmaxf(va[r], vb[r])); }
            }
            vmax = fmaxf(vmax, __shfl_xor(vmax, 16)); vmax = fmaxf(vmax, __shfl_xor(vmax, 32));
            const float mnew = fmaxf(mrun[nt], vmax), alpha = __builtin_amdgcn_exp2f(mrun[nt] - mnew);
            const bool moved = __any(mnew != mrun[nt]); mrun[nt] = mnew;
            f32x4 pa, pbv; float ps = 0.f;
#pragma unroll
            for (int r = 0; r < 4; ++r) { pa[r] = __builtin_amdgcn_exp2f(va[r] - mnew); pbv[r] = __builtin_amdgcn_exp2f(vb[r] - mnew); ps += pa[r] + pbv[r]; }
            lrun[nt] = lrun[nt] * alpha + ps;
            if (moved) {
#pragma unroll
                for (int mt = 0; mt < 4; ++mt) O[mt][nt] = O[mt][nt] * alpha; }
            pb[nt] = pack_ab(pa, pbv);
        }
#pragma unroll
        for (int mt = 0; mt < 4; ++mt)
#pragma unroll
            for (int nt = 0; nt < 2; ++nt) O[mt][nt] = MFMA16(vf[mt], pb[nt], O[mt][nt]);
    }
#undef ATT_LOADK
#pragma unroll
    for (int nt = 0; nt < 2; ++nt) { const int h = kv * 4 + hh * 2 + nt;
        float l = lrun[nt]; l += __shfl_xor(l, 16); l += __shfl_xor(l, 32); const float inv = (1.0f / 255.0f) / l;
#pragma unroll
        for (int mt = 0; mt < 4; ++mt) { const int col = h * 64 + 16 * mt + 4 * g;
            const unsigned gq = *(const unsigned*)(GQ + (tok >> 4) * 32768 + ((1024 + col) >> 4) * 256 + c * 16 + 4 * g);
            const f32x4 o = O[mt][nt] * inv;
            int w = 0; w = __builtin_amdgcn_cvt_pk_fp8_f32(o[0] * (float)(gq & 255u), o[1] * (float)((gq >> 8) & 255u), w, false); w = __builtin_amdgcn_cvt_pk_fp8_f32(o[2] * (float)((gq >> 16) & 255u), o[3] * (float)(gq >> 24), w, true);
            *(unsigned*)((unsigned char*)YA + ya_stripe(tok) + (col >> 4) * 256 + lane * 4) = (unsigned)w; } }
}

DI void transpose_item(const float* W, int N, int K, int k0, int in_col0, bf16* WT, int out_row0, LAS float* scr, int lane) {
    float tmp_[32];
#pragma unroll
    for (int i = 0; i < 32; ++i) { const int kk = 2 * i + (lane >> 5); tmp_[i] = W[(size_t)(k0 + kk) * N + in_col0 + (lane & 31)]; }
#pragma unroll
    for (int i = 0; i < 32; ++i) { const int kk = 2 * i + (lane >> 5); scr[kk * 33 + (lane & 31)] = tmp_[i]; }
    asm volatile("s_waitcnt lgkmcnt(0)" ::: "memory");
    const int c = lane & 7;
#pragma unroll
    for (int j = 0; j < 4; ++j) { const int n = (lane >> 3) + 8 * j; const LAS float* s = scr + (8 * c) * 33 + n;
        v4u o; o.x = pk2(s[0 * 33], s[1 * 33]); o.y = pk2(s[2 * 33], s[3 * 33]); o.z = pk2(s[4 * 33], s[5 * 33]); o.w = pk2(s[6 * 33], s[7 * 33]);
        *(v4u*)(WT + (size_t)(out_row0 + n) * K + k0 + 8 * c) = o; }
    asm volatile("s_waitcnt lgkmcnt(0)" ::: "memory");
}


DI void transpose_item8(const float* W, int N, int K, int k0, int in_col0, unsigned char* WT, int out_row0, LAS float* scr, int lane) {
    float tmp_[32];
#pragma unroll
    for (int i = 0; i < 32; ++i) { const int kk = 2 * i + (lane >> 5); tmp_[i] = W[(size_t)(k0 + kk) * N + in_col0 + (lane & 31)]; }
#pragma unroll
    for (int i = 0; i < 32; ++i) { const int kk = 2 * i + (lane >> 5); scr[kk * 33 + (lane & 31)] = tmp_[i]; }
    asm volatile("s_waitcnt lgkmcnt(0)" ::: "memory");
    const int c = lane & 7;
#pragma unroll
    for (int j = 0; j < 4; ++j) { const int n = (lane >> 3) + 8 * j; const LAS float* s = scr + (8 * c) * 33 + n;
        int w0 = 0, w1 = 0;
        w0 = __builtin_amdgcn_cvt_pk_fp8_f32(s[0 * 33] * W8_SCALE, s[1 * 33] * W8_SCALE, w0, false); w0 = __builtin_amdgcn_cvt_pk_fp8_f32(s[2 * 33] * W8_SCALE, s[3 * 33] * W8_SCALE, w0, true);
        w1 = __builtin_amdgcn_cvt_pk_fp8_f32(s[4 * 33] * W8_SCALE, s[5 * 33] * W8_SCALE, w1, false); w1 = __builtin_amdgcn_cvt_pk_fp8_f32(s[6 * 33] * W8_SCALE, s[7 * 33] * W8_SCALE, w1, true);
        *(uint2*)(WT + (size_t)(out_row0 + n) * K + k0 + 8 * c) = make_uint2((unsigned)w0, (unsigned)w1); }
    asm volatile("s_waitcnt lgkmcnt(0)" ::: "memory");
}


DI void conv_issue(const float* src, int N, int lane, float (&tmp)[32]) {
    const unsigned long long a = (unsigned long long)src;
    const float* su = (const float*)(((unsigned long long)(unsigned)__builtin_amdgcn_readfirstlane((int)(a >> 32)) << 32) | (unsigned)__builtin_amdgcn_readfirstlane((int)a));
    const int Nu = __builtin_amdgcn_readfirstlane(N);
    const __amdgpu_buffer_rsrc_t rs = __builtin_amdgcn_make_buffer_rsrc((void*)su, (short)0, 64 * Nu * 4, 0x00020000);
    const int voff = ((lane >> 3) * Nu + (lane & 7) * 4) * 4;
#pragma unroll
    for (int i = 0; i < 8; ++i) { const v4u q = __builtin_amdgcn_raw_buffer_load_b128(rs, voff, 8 * i * Nu * 4, 2);
        tmp[4 * i] = __uint_as_float(q.x); tmp[4 * i + 1] = __uint_as_float(q.y); tmp[4 * i + 2] = __uint_as_float(q.z); tmp[4 * i + 3] = __uint_as_float(q.w); }
}
DI void conv_finish(const float (&tmp)[32], unsigned char* dst, int K, LAS float* scr, int lane) {
#pragma unroll
    for (int i = 0; i < 8; ++i) { const int kk = 8 * i + (lane >> 3), n4 = (lane & 7) * 4;
#pragma unroll
        for (int c = 0; c < 4; ++c) scr[kk * 33 + n4 + c] = tmp[4 * i + c]; }
    asm volatile("s_waitcnt lgkmcnt(0)" ::: "memory");
    const int c = lane & 7;
#pragma unroll
    for (int j = 0; j < 4; ++j) { const int n = (lane >> 3) + 8 * j; const LAS float* s = scr + (8 * c) * 33 + n;
        int w0 = 0, w1 = 0;
        w0 = __builtin_amdgcn_cvt_pk_fp8_f32(s[0 * 33] * W8_SCALE, s[1 * 33] * W8_SCALE, w0, false); w0 = __builtin_amdgcn_cvt_pk_fp8_f32(s[2 * 33] * W8_SCALE, s[3 * 33] * W8_SCALE, w0, true);
        w1 = __builtin_amdgcn_cvt_pk_fp8_f32(s[4 * 33] * W8_SCALE, s[5 * 33] * W8_SCALE, w1, false); w1 = __builtin_amdgcn_cvt_pk_fp8_f32(s[6 * 33] * W8_SCALE, s[7 * 33] * W8_SCALE, w1, true);
        { typedef unsigned u32x2_ __attribute__((ext_vector_type(2))); const u32x2_ o2 = {(unsigned)w0, (unsigned)w1}; __builtin_nontemporal_store(o2, (u32x2_*)(dst + (size_t)n * K + 8 * c)); } }
    asm volatile("s_waitcnt lgkmcnt(0)" ::: "memory");
}
DI void moe_item_desc(int r, const float* w_ug, const float* w_d, unsigned char* WUG, unsigned char* WD, const float*& src, int& N, unsigned char*& dst) {
    constexpr int I_UG = NE * 16 * 64;
    if (r < I_UG) { const int e = r / (16 * 64), q = r % (16 * 64), kb = q / 64, nb = q % 64; N = 2048;
        src = w_ug + (size_t)e * D * 2048 + (size_t)(kb * 64) * 2048 + wug_row_to_col(nb * 32); dst = WUG + (size_t)e * 2048 * D + (size_t)(nb * 32) * D + kb * 64; }
    else { r -= I_UG; const int e = r / (16 * 32), q = r % (16 * 32), kb = q / 32, nb = q % 32; N = D;
        src = w_d + (size_t)e * D * D + (size_t)(kb * 64) * D + nb * 32; dst = WD + (size_t)e * D * D + (size_t)(nb * 32) * D + kb * 64; }
}

DI void conv_batch4(int cit, int stride, const float* w_ug, const float* w_d, unsigned char* WUG, unsigned char* WD, LAS float* scr, int lane) {
    float t0[32], t1[32], t2[32], t3[32]; const float *s0, *s1, *s2, *s3; unsigned char *d0, *d1, *d2, *d3; int n0, n1, n2, n3;
    moe_item_desc(cit, w_ug, w_d, WUG, WD, s0, n0, d0); conv_issue(s0, n0, lane, t0);
    moe_item_desc(cit + stride, w_ug, w_d, WUG, WD, s1, n1, d1); conv_issue(s1, n1, lane, t1);
    moe_item_desc(cit + 2 * stride, w_ug, w_d, WUG, WD, s2, n2, d2); conv_issue(s2, n2, lane, t2);
    moe_item_desc(cit + 3 * stride, w_ug, w_d, WUG, WD, s3, n3, d3); conv_issue(s3, n3, lane, t3);
    conv_finish(t0, d0, D, scr, lane); conv_finish(t1, d1, D, scr, lane); conv_finish(t2, d2, D, scr, lane); conv_finish(t3, d3, D, scr, lane);
}

#define XB_TMO      128
#define XB_XCNT(j)  (256  + 64 * (j))
#define XB_XSUB(j)  (1280 + 64 * (j))
#define XB_XGEN(j)  (2304 + 64 * (j))
#define XB_TOP      3328
#define XB_TOPGEN   3392
#define XCD_BAR_WORDS 3456
#define XB_SPIN_CAP (1u << 18)

__device__ __forceinline__ unsigned xb_ld(unsigned* p)              { return __hip_atomic_load(p, __ATOMIC_RELAXED, __HIP_MEMORY_SCOPE_AGENT); }
__device__ __forceinline__ unsigned xb_add(unsigned* p, unsigned v) { return __hip_atomic_fetch_add(p, v, __ATOMIC_RELAXED, __HIP_MEMORY_SCOPE_AGENT); }
__device__ __forceinline__ unsigned xb_xcc_id() { return (unsigned)__builtin_amdgcn_s_getreg((3 << 11) | 20) & 0xFu; }
#define XB_SPIN(cond, bar) do { unsigned _sp = 0; while (cond) { __builtin_amdgcn_s_sleep(1); \
    if ((++_sp & 255u) == 0u) { if (xb_ld(&(bar)[XB_TMO])) break; if (_sp > XB_SPIN_CAP) { atomicAdd(&(bar)[XB_TMO], 1u); break; } } } } while (0)

struct XcdBarrier {
    unsigned* bar; unsigned x;
    volatile LAS unsigned* st;
};

__device__ __forceinline__ XcdBarrier xcd_barrier_post(unsigned* bar, volatile LAS unsigned* st) {
    XcdBarrier b; b.bar = bar; b.x = xb_xcc_id(); b.st = st;
    if (threadIdx.x == 0) (void)xb_add(&bar[XB_XCNT(b.x)], 1u);
    return b;
}
__device__ __forceinline__ void xcd_barrier_complete(unsigned* bar, unsigned x, unsigned& nloc, unsigned& nx) {
    const unsigned G = gridDim.x * gridDim.y * gridDim.z;
    unsigned sum, cnt, mine, sp = 0u;
    for (;;) {
        sum = 0u; cnt = 0u; mine = 0u;
#pragma unroll
        for (unsigned j = 0; j < 16; ++j) { const unsigned c = xb_ld(&bar[XB_XCNT(j)]); sum += c; cnt += (c > 0u) ? 1u : 0u; mine = (j == x) ? c : mine; }
        if (sum == G) break;
        __builtin_amdgcn_s_sleep(1);
        if ((++sp & 255u) == 0u) { if (xb_ld(&bar[XB_TMO])) break; if (sp > XB_SPIN_CAP) { atomicAdd(&bar[XB_TMO], 1u); break; } }
    }
    nloc = mine > 0u ? mine : 1u; nx = cnt > 0u ? cnt : 1u;
}

__device__ __forceinline__ void xcd_barrier(const XcdBarrier& b) {
    asm volatile("s_waitcnt vmcnt(0)" ::: "memory");
    __syncthreads();
    if (threadIdx.x == 0) {
        unsigned* bar = b.bar;
        __builtin_amdgcn_s_waitcnt(0);
        unsigned nloc = b.st[0], nx = b.st[1];
        if (nloc == 0u) { xcd_barrier_complete(bar, b.x, nloc, nx); b.st[0] = nloc; b.st[1] = nx; }
        const unsigned old = xb_add(&bar[XB_XSUB(b.x)], 1u);
        const unsigned gen = old / nloc;
        if (old + 1u == (gen + 1u) * nloc) {
            __builtin_amdgcn_fence(__ATOMIC_RELEASE, "agent");
            asm volatile("s_waitcnt vmcnt(0)" ::: "memory");
            (void)xb_add(&bar[XB_TOP], 1u);
            XB_SPIN(xb_ld(&bar[XB_TOP]) < (gen + 1u) * nx, bar);
            __builtin_amdgcn_fence(__ATOMIC_ACQUIRE, "agent");
            asm volatile("s_waitcnt vmcnt(0)" ::: "memory");
        } else {
            __builtin_amdgcn_fence(__ATOMIC_ACQUIRE, "agent");
            asm volatile("s_waitcnt vmcnt(0)" ::: "memory");
            XB_SPIN(xb_ld(&bar[XB_TOP]) < (gen + 1u) * nx, bar);
        }
    }
    __syncthreads();
}

struct Args { const float* in[16]; float* out; unsigned char* ws; int ph_lo, ph_hi, li, pad; };
__global__ void __launch_bounds__(NTHREADS, 2) mk_fwd(Args args) {
    extern __shared__ __attribute__((aligned(16))) unsigned char lds[];
    LAS unsigned char* L = (LAS unsigned char*)lds;
    const int tid = threadIdx.x, lane = tid & 63, wave = __builtin_amdgcn_readfirstlane(tid >> 6), G = gridDim.x, bx = blockIdx.x;
    const int vcu = (G % 8 == 0) ? (bx % 8) * (G / 8) + bx / 8 : bx;
    const int gw = vcu * NWAVES + wave, NGW = G * NWAVES;
    unsigned char* ws = args.ws;
    const float* x = args.in[0]; const float* g_mix = args.in[1]; const float* w_in = args.in[2]; const float* lbf = args.in[3]; const float* lbb = args.in[4];
    const float* w_out = args.in[7]; const float* w_ug = args.in[11]; const float* b_ug = args.in[12]; const float* w_d = args.in[13]; const float* b_d = args.in[14];
    unsigned* ctl = (unsigned*)(ws + WS_CTL);
    unsigned char *WUG = ws + WS_WUG, *WD = ws + WS_WD, *ACT = ws + WS_ACT;
    bf16 *WOUT = (bf16*)(ws + WS_WOUT), *WIN_ = (bf16*)(ws + WS_WIN), *XN = (bf16*)(ws + WS_XN), *PN = (bf16*)(ws + WS_PN), *PT = (bf16*)(ws + WS_PT),
         *MG = (bf16*)(ws + WS_MERGED), *YB = (bf16*)(ws + WS_YB);
    bf16* H = (bf16*)(ws + WS_H);
    float* GS = (float*)(ws + WS_CTL + 524288);
    int* tk_e = (int*)(ws + WS_TK); int* tk_slot = tk_e + T * 4; float* tk_gate = (float*)(tk_slot + T * 4); int* tk_dest = (int*)(tk_gate + T * 4);
    const int lo = args.ph_lo, hi = args.ph_hi;
#define IN(k) (lo <= (k) && (k) < hi)
    volatile LAS unsigned* MISC = (volatile LAS unsigned*)(L + LDSCTL_OFF);
    if (tid < 16) MISC[tid] = 0u;
    __syncthreads();
    XcdBarrier bar; bar.bar = ctl + CW_BAR + args.li * XCD_BAR_WORDS; bar.x = 0; bar.st = nullptr;
    if (hi - lo > 1) bar = xcd_barrier_post(ctl + CW_BAR + args.li * XCD_BAR_WORDS, MISC + 8);
#define BAR(k) do { if (IN(k) && IN((k) + 1)) xcd_barrier(bar); } while (0)

    if (IN(0)) {
        LAS float* scr = (LAS float*)(L + wave * 16384);
        constexpr int I_IN = 16 * (INW / 32), I_OUT = 16 * 32, NITEMS = I_IN + I_OUT;
        for (int it = gw; it < NITEMS; it += NGW) {
            int r = it;
            if (r < I_IN) { const int kb = r / (INW / 32), nb = r % (INW / 32), orow = nb * 32; const bool f8 = (orow >= NAT16 && orow < NATW + TR8);
                if (f8) transpose_item8(w_in, INW, D, kb * 64, win_row_to_col(orow), ws + WS_WIN8, orow, scr, lane); else transpose_item(w_in, INW, D, kb * 64, win_row_to_col(orow), WIN_, orow, scr, lane); continue; } r -= I_IN;
            { const int kb = r / 32, nb = r % 32; transpose_item8(w_out, D, D, kb * 64, nb * 32, ws + WS_WOUT, nb * 32, scr, lane); }
        }
        for (int i = vcu * NTHREADS + tid; i < 2048; i += G * NTHREADS) { const float* tb = (i >> 10) ? lbb : lbf; const int c_ = i & 1023;
            const float lb = __builtin_amdgcn_rcpf(1.0f + __builtin_amdgcn_exp2f((tb[1024 + c_] - tb[c_]) * 1.4426950408889634f));
            GS[i] = fminf(__builtin_amdgcn_logf(lb), -1e-6f) * (0.6931471805599453f / 255.0f); }
        for (int m = gw; m < T; m += NGW) {
            const f32x4* xr = (const f32x4*)(x + (size_t)m * D) + lane; const f32x4* gr = (const f32x4*)g_mix + lane;
            f32x4 v[4]; float s = 0.f;
#pragma unroll
            for (int j = 0; j < 4; ++j) { v[j] = xr[64 * j]; s += (v[j].x * v[j].x + v[j].y * v[j].y) + (v[j].z * v[j].z + v[j].w * v[j].w); }
            const float rstd = rsqrtf(wave_sum(s) * (1.0f / D) + EPS);
            unsigned long long* o8 = (unsigned long long*)(XN + (size_t)m * D) + lane;
            unsigned* o4 = (unsigned*)(ws + WS_XN8 + (size_t)m * D) + lane;
#pragma unroll
            for (int j = 0; j < 4; ++j) { const f32x4 g = gr[64 * j]; const float a0 = v[j].x * rstd * g.x, a1 = v[j].y * rstd * g.y, a2 = v[j].z * rstd * g.z, a3 = v[j].w * rstd * g.w;
                o8[64 * j] = (unsigned long long)pk2(a0, a1) | ((unsigned long long)pk2(a2, a3) << 32);
                int w = 0; w = __builtin_amdgcn_cvt_pk_fp8_f32(a0, a1, w, false); w = __builtin_amdgcn_cvt_pk_fp8_f32(a2, a3, w, true); o4[64 * j] = (unsigned)w; }
        }
    }
    BAR(0);
    if (IN(1)) {
        const bf16* XN8 = (const bf16*)(ws + WS_XN8); const unsigned char* WIN8 = ws + WS_WIN8;
        { pg8::Gemm g{XN, WIN_, T, NAT16, D}; pg8::StaticOrder S; S.init(T, NAT16, G, bx); pg8::EpiNatMk<false> E{PN, 0, nullptr, nullptr};
          pg8::gemm_phase<pg8::EpiNatMk<false>, pg8::StaticOrder, true, true>(L, g, S, E); }
        { pg8::Gemm g{WIN_ + (size_t)(NATW + TR8) * D, XN, TRW - TR8, T, D}; pg8::StaticOrder S; S.init(TRW - TR8, T, G, G - 1 - bx); pg8::EpiTrMk<false> E{PT, lbf, lbb, TR8 / 256};
          pg8::gemm_phase<pg8::EpiTrMk<false>, pg8::StaticOrder, true, true>(L, g, S, E); }
        { pg8::Gemm g{XN8, (const bf16*)(WIN8 + (size_t)NAT16 * D), T, NATW - NAT16, D / 2}; pg8::StaticOrder S; S.init(T, NATW - NAT16, G, bx); pg8::EpiNatMk<true> E{PN, NAT16 / 256, ws + WS_GQ, ws + WS_AQ8};
          pg8::gemm_phase<pg8::EpiNatMk<true>, pg8::StaticOrder, true, true, true>(L, g, S, E); }
        { pg8::Gemm g{(const bf16*)(WIN8 + (size_t)NATW * D), XN8, TR8, T, D / 2}; pg8::StaticOrder S; S.init(TR8, T, G, bx); pg8::EpiTrMk<true> E{PT, lbf, lbb, 0};
          pg8::gemm_phase<pg8::EpiTrMk<true>, pg8::StaticOrder, true, true, true>(L, g, S, E); }
        if (G == 256 && bx >= PRE_LO && bx < PRE_HI) {
            LAS float* scr = (LAS float*)(L + wave * 16384); const int pw = (bx - PRE_LO) * NWAVES + wave, pstride = (PRE_HI - PRE_LO) * NWAVES;
            for (int b = 0; b < PRE_NB; ++b) conv_batch4(pw + b * 4 * pstride, pstride, w_ug, w_d, WUG, WD, scr, lane);
        }
    }
    BAR(1);
    if (IN(2)) {
        const float* sink = args.in[6]; bf16* YA = (bf16*)(ws + WS_YA);
        constexpr int NU = NB * AKH * (SEQ / 16);
        LAS float* scr = (LAS float*)(L + wave * 16384);
        constexpr int I_UG = NE * 16 * 64, I_D = NE * 16 * 32, NCONV_ALL = I_UG + I_D; const int NCONV = NCONV_ALL - (G == 256 ? NP8 : 0);
        int cit = (G == 256 ? NPRE : 0) + gw;
#define CONV_ITEMS(n_) do { for (int q_ = 0; q_ < (n_) && cit < NCONV; q_ += 4) { \
            if (cit + 3 * NGW < NCONV) { conv_batch4(cit, NGW, w_ug, w_d, WUG, WD, scr, lane); cit += 4 * NGW; } \
            else { const float* s0_; unsigned char* d0_; int n0_; float t0_[32]; moe_item_desc(cit, w_ug, w_d, WUG, WD, s0_, n0_, d0_); conv_issue(s0_, n0_, lane, t0_); conv_finish(t0_, d0_, D, scr, lane); cit += NGW; } } } while (0)
        if (wave >= 4) CONV_ITEMS(8);
        for (int u = gw; u < 2 * NU; u += NGW) { const int qt = u % (SEQ / 16), hh = (u / (SEQ / 16)) & 1, kv = (u / (SEQ / 8)) % AKH, b = u / (SEQ / 8 * AKH); attn_unit(PN, ws + WS_AQ8, ws + WS_GQ, PT, sink, YA, b, kv, qt, hh, lane); CONV_ITEMS(4); }
        { const int dir = wave & 1; const HgConst K = hg_make_const(lane, dir); unsigned char* U = ws + WS_U; float* DEC = (float*)(ws + WS_DEC);
          for (int i = gw >> 1; i < 2048; i += NGW / 2) { hg_pass1(PT, GS, U, DEC, i * 2 + dir, lane, K, dir); CONV_ITEMS(4); } }
        CONV_ITEMS(1 << 30);
#undef CONV_ITEMS
    }
    BAR(2);
    if (IN(3)) {
        const unsigned char* U = ws + WS_U; unsigned char* Sst = ws + WS_OF; const float* DEC = (const float*)(ws + WS_DEC);
        for (int i = vcu * NTHREADS + tid; i < 32 * 4096; i += G * NTHREADS) {
            const int el4 = i & 4095, chain = i >> 12, dir = chain & 1, bh = chain >> 1, d4 = 32 * ((el4 >> 7) & 3) + 16 * (el4 & 1) + 4 * ((el4 >> 5) & 3);
            f32x4 st = Z4;
            const unsigned char* ub = U + (size_t)bh * 128 * 2 * 16384 + (size_t)dir * 16384 + el4 * 4; unsigned char* sb_ = Sst + (size_t)bh * 128 * 2 * 16384 + (size_t)dir * 16384 + el4 * 4; const float* db = DEC + (size_t)bh * 128 * 2 * 128 + dir * 128 + d4;
#pragma unroll 1
            for (int k0 = 0; k0 < NCH; k0 += 8) {
                unsigned u[8]; f32x4 dc[8];
#pragma unroll
                for (int j = 0; j < 8; ++j) { const int n = dir ? NCH - 1 - (k0 + j) : (k0 + j); u[j] = *(const unsigned*)(ub + (size_t)n * 2 * 16384); dc[j] = *(const f32x4*)(db + (size_t)n * 2 * 128); }
#pragma unroll
                for (int j = 0; j < 8; ++j) { const int n = dir ? NCH - 1 - (k0 + j) : (k0 + j);
                    *(unsigned*)(sb_ + (size_t)n * 2 * 16384) = pk4_fp8(st[0], st[1], st[2], st[3]);
                    const f32x2_t lo = __builtin_amdgcn_cvt_pk_f32_fp8((int)u[j], false), hi = __builtin_amdgcn_cvt_pk_f32_fp8((int)u[j], true);
                    st[0] = dc[j][0] * st[0] + lo[0]; st[1] = dc[j][1] * st[1] + lo[1]; st[2] = dc[j][2] * st[2] + hi[0]; st[3] = dc[j][3] * st[3] + hi[1]; }
            }
        }
    }
    BAR(3);
    if (IN(4)) {
        const unsigned char* U = ws + WS_OF; const bf16* YA = (const bf16*)(ws + WS_YA); const float* gng = args.in[5];
        const int dir = wave & 1, pr = wave >> 1; const HgConst K = hg_make_const(lane, dir);
        LAS unsigned char* myslot = L + pr * 32768 + dir * 16384; LAS unsigned char* oslot = L + pr * 32768 + (dir ^ 1) * 16384;
        LAS float* myss = (LAS float*)(L + SS_OFF + wave * 1024); LAS float* oss = (LAS float*)(L + SS_OFF + (wave ^ 1) * 1024);
        for (int wi = vcu; wi < 512; wi += G) { const int bhn = wi * 4 + pr;
            f32x4 keep[4][4];
            if (dir) hg_pass3_a<1>(PN, PT, GS, U, bhn, lane, K, keep, myslot); else hg_pass3_a<0>(PN, PT, GS, U, bhn, lane, K, keep, myslot);
            HgC cin; hg_pass3_c_load(PN, ws + WS_GQ, YA, bhn, lane, dir, cin);
            __syncthreads();
            hg_pass3_b(lane, keep, oslot, myss);
            __syncthreads();
            hg_pass3_c(cin, gng, MG, bhn, lane, dir, keep, myss, oss);
            __syncthreads();
        }
    }
    BAR(4);
    if (IN(5)) {
        pg8::Gemm g{MG, WOUT, T, D, D / 2}; pg8::StaticOrder S; S.init(T, D, G, bx); pg8::EpiResidMk E{x, H};
        pg8::gemm_phase<pg8::EpiResidMk, pg8::StaticOrder, true, true, true>(L, g, S, E);
    }
    BAR(5);
    if (IN(6)) {
        const float* g_ffn = args.in[8]; const float* w_r = args.in[9]; const float* b_r = args.in[10];
        unsigned char* XN2 = ws + WS_XN2; int* elist = (int*)(ws + WS_XG);
        constexpr int WPB = 1032; LAS bf16* Whi = (LAS bf16*)L; LAS bf16* Wlo = Whi + 32 * WPB;
        static_assert(2 * 32 * WPB * 2 <= LDSCTL_OFF, "router tables");
        { f32x4 wq[16]; float gk[16];
#pragma unroll
          for (int q = 0; q < 16; ++q) { const int i4 = tid + q * NTHREADS; wq[q] = ((const f32x4*)w_r)[i4]; gk[q] = g_ffn[i4 >> 3]; }
#pragma unroll
          for (int q = 0; q < 16; ++q) { const int i4 = tid + q * NTHREADS, k = i4 >> 3, e = (i4 & 7) * 4;
#pragma unroll
              for (int t = 0; t < 4; ++t) { const float w = wq[q][t] * gk[q]; const bf16 hi = f2bf(w); Whi[(e + t) * WPB + k] = hi; Wlo[(e + t) * WPB + k] = f2bf(w - bf2f(hi)); } } }
        volatile LAS int* lcnt = (volatile LAS int*)(L + META_OFF);
        LAS int* asg = (LAS int*)(L + SS_OFF);
        LAS float* lg = (LAS float*)(L + SS_OFF + 1024);
        const int c = lane & 15, g = lane >> 4, mt = wave >> 1, nt = wave & 1;
        for (int blk = vcu; blk < T / 64; blk += G) {
            if (tid < 32) lcnt[tid] = 0;
            __syncthreads();
            v4u hq[8][2];
#pragma unroll
            for (int rr = 0; rr < 8; ++rr) { const v4u* hr = (const v4u*)(H + (size_t)(blk * 64 + wave * 8 + rr) * D) + lane; hq[rr][0] = hr[0]; hq[rr][1] = hr[64]; }
            f32x4 gq4[4]; { const f32x4* gr = (const f32x4*)g_ffn + 2 * lane; gq4[0] = gr[0]; gq4[1] = gr[1]; gq4[2] = gr[128]; gq4[3] = gr[129]; }
#pragma unroll
            for (int rr = 0; rr < 8; ++rr) { const int row = blk * 64 + wave * 8 + rr;
                f32x4 v[4]; float ssq = 0.f;
#pragma unroll
                for (int j = 0; j < 2; ++j) { const v4u q = hq[rr][j];
                    v[2 * j] = (f32x4){__uint_as_float(q.x << 16), __uint_as_float(q.x & 0xffff0000u), __uint_as_float(q.y << 16), __uint_as_float(q.y & 0xffff0000u)};
                    v[2 * j + 1] = (f32x4){__uint_as_float(q.z << 16), __uint_as_float(q.z & 0xffff0000u), __uint_as_float(q.w << 16), __uint_as_float(q.w & 0xffff0000u)}; }
#pragma unroll
                for (int j = 0; j < 4; ++j) ssq += (v[j].x * v[j].x + v[j].y * v[j].y) + (v[j].z * v[j].z + v[j].w * v[j].w);
                const float rstd = rsqrtf(wave_sum(ssq) * (1.0f / D) + EPS);
                uint2* o8 = (uint2*)(XN2 + (size_t)row * D) + lane;
#pragma unroll
                for (int j = 0; j < 2; ++j) { int w[2];
#pragma unroll
                    for (int hh = 0; hh < 2; ++hh) { const f32x4 t = v[2 * j + hh] * rstd * gq4[2 * j + hh]; int ww = 0; ww = __builtin_amdgcn_cvt_pk_fp8_f32(t.x, t.y, ww, false); ww = __builtin_amdgcn_cvt_pk_fp8_f32(t.z, t.w, ww, true); w[hh] = ww; }
                    o8[64 * j] = make_uint2((unsigned)w[0], (unsigned)w[1]); } }
            { const bf16* hb = H + (size_t)(blk * 64 + 16 * mt + c) * D + 8 * g; const LAS bf16* wh = Whi + (16 * nt + c) * WPB + 8 * g; const LAS bf16* wl = Wlo + (16 * nt + c) * WPB + 8 * g;
              f32x4 acc = Z4; float ssq = 0.f;
#pragma unroll 8
              for (int q = 0; q < 32; ++q) { const v4u aq = *(const v4u*)(hb + 32 * q); const bf16x8 bh = *(const LAS bf16x8*)(wh + 32 * q), bl = *(const LAS bf16x8*)(wl + 32 * q);
                  const f32x4 a0 = {__uint_as_float(aq.x << 16), __uint_as_float(aq.x & 0xffff0000u), __uint_as_float(aq.y << 16), __uint_as_float(aq.y & 0xffff0000u)};
                  const f32x4 a1 = {__uint_as_float(aq.z << 16), __uint_as_float(aq.z & 0xffff0000u), __uint_as_float(aq.w << 16), __uint_as_float(aq.w & 0xffff0000u)};
                  ssq += ((a0.x * a0.x + a0.y * a0.y) + (a0.z * a0.z + a0.w * a0.w)) + ((a1.x * a1.x + a1.y * a1.y) + (a1.z * a1.z + a1.w * a1.w));
                  const bf16x8 a = __builtin_bit_cast(bf16x8, aq);
                  acc = MFMA16(a, bh, acc); acc = MFMA16(a, bl, acc); }
              ssq += __shfl_xor(ssq, 16); ssq += __shfl_xor(ssq, 32);
              const float rstd = rsqrtf(ssq * (1.0f / D) + EPS); const float bias = b_r[16 * nt + c];
#pragma unroll
              for (int r = 0; r < 4; ++r) { const float rs = __shfl(rstd, 4 * g + r); lg[(16 * mt + 4 * g + r) * 33 + 16 * nt + c] = acc[r] * rs + bias; } }
            __syncthreads();
            if (tid < 64) { const int row = blk * 64 + tid; float lv[32];
#pragma unroll
                for (int e = 0; e < 32; ++e) lv[e] = lg[tid * 33 + e];
                float tv[4]; int te[4];
#pragma unroll
                for (int k = 0; k < 4; ++k) { float m = -INFINITY; int mi = 0;
#pragma unroll
                    for (int e = 0; e < 32; ++e) { const bool used = (k > 0 && te[0] == e) || (k > 1 && te[1] == e) || (k > 2 && te[2] == e); if (!used && lv[e] > m) { m = lv[e]; mi = e; } }
                    tv[k] = m; te[k] = mi; }
                const float e1 = __expf(tv[1] - tv[0]), e2 = __expf(tv[2] - tv[0]), e3 = __expf(tv[3] - tv[0]); const float inv = 1.0f / (1.0f + e1 + e2 + e3);
                const float gts[4] = {inv, e1 * inv, e2 * inv, e3 * inv};
#pragma unroll
                for (int k = 0; k < 4; ++k) { tk_e[row * 4 + k] = te[k]; tk_gate[row * 4 + k] = gts[k];
                    const int ls = __hip_atomic_fetch_add((LAS int*)(L + META_OFF) + te[k], 1, __ATOMIC_RELAXED, __HIP_MEMORY_SCOPE_WORKGROUP); asg[tid * 4 + k] = (te[k] << 16) | ls; } }
            __syncthreads();
            if (tid < 32) lcnt[32 + tid] = (int)atomicAdd(&ctl[CW_CNT + tid * CNT_STRIDE], (unsigned)lcnt[tid]);
            __syncthreads();
            if (tid < 256) { const int pk = asg[tid], e_ = pk >> 16, gs = lcnt[32 + e_] + (pk & 0xffff); tk_slot[blk * 256 + tid] = gs; elist[(size_t)e_ * 16384 + gs] = blk * 64 + (tid >> 2); }
            __syncthreads();
        }
    }
    if (IN(6) && IN(8)) xcd_barrier(bar);
#define MOE_META(NCT_) do { __syncthreads(); \
        if (tid < 32) { const int cnt_ = (int)__hip_atomic_load(ctl + CW_CNT + tid * CNT_STRIDE, __ATOMIC_RELAXED, __HIP_MEMORY_SCOPE_AGENT);     \
            const int nt = (cnt_ + 255) >> 8; int pt = nt; \
            _Pragma("unroll") for (int o = 1; o < 32; o <<= 1) { const int v_ = __shfl_up(pt, o); pt += (tid >= o) ? v_ : 0; }     \
            const int tb = pt - nt; meta[tid] = tb * (NCT_); meta[40 + tid] = tb; meta[80 + tid] = nt > 0 ? nt : 1; meta[120 + tid] = cnt_; if (tid == 31) meta[32] = pt * (NCT_); } \
        __syncthreads(); } while (0)
    if (IN(8)) {
        volatile LAS int* meta = (volatile LAS int*)(L + META_OFF);
        MOE_META(8);
        pg8::MoeOrder<true> S{meta, 8, G, bx, (const int*)(ws + WS_XG), ctl + CW_RDY, nullptr, nullptr}; pg8::Gemm g{(const bf16*)(ws + WS_XN2), (const bf16*)WUG, NPAD, NE * 2048, D / 2}; pg8::EpiSwigluMk E{ACT, b_ug};
        pg8::gemm_phase<pg8::EpiSwigluMk, pg8::MoeOrder<true>, true, true, true>(L, g, S, E);
    }
    if (IN(9)) {
        volatile LAS int* meta = (volatile LAS int*)(L + META_OFF);
        MOE_META(4);
        volatile LAS int* hflags = (volatile LAS int*)(L + SS_OFF); if (tid < 4) hflags[tid] = 0;
        if (tid == 0) { __builtin_amdgcn_fence(__ATOMIC_ACQUIRE, "agent"); asm volatile("s_waitcnt vmcnt(0)" ::: "memory"); }
        __syncthreads();
        pg8::MoeOrder<false> S{meta, 4, G, G - 1 - bx, nullptr, ctl + CW_RDY, hflags, ctl + CW_BAR + XB_TMO}; pg8::Gemm g{(const bf16*)ACT, (const bf16*)WD, NPAD, NE * D, D / 2}; pg8::EpiDownMk E{(unsigned char*)YB, b_d};
        pg8::gemm_phase<pg8::EpiDownMk, pg8::MoeOrder<false>, true, true, true>(L, g, S, E);
    }
#undef MOE_META
    BAR(9);
    if (IN(10)) {
        const float* g_fin = args.in[15];
        volatile LAS int* meta = (volatile LAS int*)(L + META_OFF);
        __syncthreads();
        if (tid < 32) { const int pr_ = (int)((__hip_atomic_load(ctl + CW_CNT + tid * CNT_STRIDE, __ATOMIC_RELAXED, __HIP_MEMORY_SCOPE_AGENT) + 255u) & ~255u); int pt = pr_;
#pragma unroll
            for (int o = 1; o < 32; o <<= 1) { const int v_ = __shfl_up(pt, o); pt += (tid >= o) ? v_ : 0; }
            meta[tid] = pt - pr_; }
        __syncthreads();
        const f32x4* gr = (const f32x4*)g_fin + lane; f32x4 gq[4];
#pragma unroll
        for (int j = 0; j < 4; ++j) gq[j] = gr[64 * j];
        for (int base = gw * 8; base < T; base += NGW * 8) {
            int my_dest = 0; float my_gate = 0.f;
            if (lane < 32) { const int a_ = base * 4 + lane; my_dest = meta[tk_e[a_]] + tk_slot[a_]; my_gate = tk_gate[a_]; }
            uint2 hA[4], hB[4], hC[4], hD[4]; unsigned yA[4][4], yB[4][4], yC[4][4], yD[4][4]; float gA[4], gB[4], gC[4], gD[4];
#define P10_LOAD(r_, h_, y_, g_) do { _Pragma("unroll") for (int k = 0; k < 4; ++k) { const int d_ = __shfl(my_dest, (r_) * 4 + k); g_[k] = __shfl(my_gate, (r_) * 4 + k); const unsigned* yp = (const unsigned*)((const unsigned char*)YB + (size_t)d_ * D) + lane; \
                _Pragma("unroll") for (int j = 0; j < 4; ++j) y_[k][j] = yp[64 * j]; } \
            { const uint2* hr = (const uint2*)(H + (size_t)(base + (r_)) * D) + lane; _Pragma("unroll") for (int j = 0; j < 4; ++j) h_[j] = hr[64 * j]; } } while (0)
#define P10_DO(r_, h_, y_, g_) do { f32x4 v[4]; _Pragma("unroll") for (int j = 0; j < 4; ++j) v[j] = (f32x4){__uint_as_float(h_[j].x << 16), __uint_as_float(h_[j].x & 0xffff0000u), __uint_as_float(h_[j].y << 16), __uint_as_float(h_[j].y & 0xffff0000u)}; \
            _Pragma("unroll") for (int k = 0; k < 4; ++k) _Pragma("unroll") for (int j = 0; j < 4; ++j) { const int w = (int)y_[k][j]; const float gt = g_[k]; const f32x2_t lo_ = __builtin_amdgcn_cvt_pk_f32_fp8(w, false), hi_ = __builtin_amdgcn_cvt_pk_f32_fp8(w, true); \
                v[j].x += gt * lo_[0]; v[j].y += gt * lo_[1]; v[j].z += gt * hi_[0]; v[j].w += gt * hi_[1]; } \
            float ssq = 0.f; _Pragma("unroll") for (int j = 0; j < 4; ++j) ssq += (v[j].x * v[j].x + v[j].y * v[j].y) + (v[j].z * v[j].z + v[j].w * v[j].w); \
            const float rstd = rsqrtf(wave_sum(ssq) * (1.0f / D) + EPS); f32x4* orow = (f32x4*)(args.out + (size_t)(base + (r_)) * D) + lane; \
            _Pragma("unroll") for (int j = 0; j < 4; ++j) orow[64 * j] = v[j] * rstd * gq[j]; } while (0)
            P10_LOAD(0, hA, yA, gA); P10_LOAD(1, hB, yB, gB); P10_LOAD(2, hC, yC, gC); P10_LOAD(3, hD, yD, gD);
            P10_DO(0, hA, yA, gA); P10_LOAD(4, hA, yA, gA); P10_DO(1, hB, yB, gB); P10_LOAD(5, hB, yB, gB); P10_DO(2, hC, yC, gC); P10_LOAD(6, hC, yC, gC); P10_DO(3, hD, yD, gD); P10_LOAD(7, hD, yD, gD);
            P10_DO(4, hA, yA, gA); P10_DO(5, hB, yB, gB); P10_DO(6, hC, yC, gC); P10_DO(7, hD, yD, gD);
#undef P10_LOAD
#undef P10_DO
        }
    }
#undef IN
#undef BAR
}

extern "C" void kernel_launch(void* const* d_in, const int* in_sizes, int n_in, void* d_out, int out_size, void* d_ws, size_t ws_size, hipStream_t stream) {
    if (n_in != 16 || in_sizes[0] != T * D || out_size != T * D || ws_size < WS_END) { fprintf(stderr, "kernel_launch: unexpected shapes / workspace (%zu < %zu)\n", ws_size, (size_t)WS_END); return; }
    char* ws = (char*)d_ws; float* out = (float*)d_out;
    (void)hipMemsetAsync(ws + WS_CTL, 0, 65536 + 288 * 64, stream);
    static int grid = 0;
    if (grid == 0) { int dev = 0, cus = 0, per_cu = 0; hipGetDevice(&dev); hipDeviceGetAttribute(&cus, hipDeviceAttributeMultiprocessorCount, dev);
        hipFuncSetAttribute((const void*)mk_fwd, hipFuncAttributeMaxDynamicSharedMemorySize, LDS_BYTES);
        hipOccupancyMaxActiveBlocksPerMultiprocessor(&per_cu, (const void*)mk_fwd, NTHREADS, LDS_BYTES);
        if (per_cu < 1) { fprintf(stderr, "kernel_launch: occupancy query says %d blocks/CU\n", per_cu); per_cu = 1; }
        (void)hipGetLastError(); grid = cus; }
    Args a{}; for (int i = 0; i < 16; ++i) a.in[i] = (const float*)d_in[i]; a.out = out; a.ws = (unsigned char*)d_ws;
#define MK(lo_, hi_) do { a.ph_lo = lo_; a.ph_hi = hi_; hipLaunchKernelGGL(mk_fwd, dim3(grid), dim3(NTHREADS), LDS_BYTES, stream, a); a.li++; } while (0)
    if (PROBE_LO < 0) { MK(0, 11); } else { MK(0, PROBE_HI); MK(PROBE_LO, PROBE_HI); if (PROBE_HI < 11) MK(PROBE_HI, 11); }
}
```
